# Optimizing an MI355X kernel written in HIP

```python
import jax, jax.numpy as jnp
from jax import lax
import numpy as np


D_MODEL = 1024
BATCH = 4
SEQ = 4096
DEPTH = 4

GRID_W = 64
CTX_LEN = 256
HEAD_DIM = 64
N_Q_HEADS = 16
N_KV_HEADS = 4
Q_PER_KV = N_Q_HEADS // N_KV_HEADS
D_ATTN = N_Q_HEADS * HEAD_DIM
D_KV = N_KV_HEADS * HEAD_DIM
D_LRU = D_MODEL
LRU_BLOCKS = 16
LRU_BLOCK = D_LRU // LRU_BLOCKS
CONV_W = 4
CONV_PAD_LEFT = 2
LRU_C = 8.0
ROPE_THETA = 10000.0
Q_BLOCK = 128
EPS = 1e-6
D_IN = 2 * D_ATTN + 2 * D_KV + 2 * D_LRU + 2 * D_MODEL

kernel_name = "hybrid_gqa_rglru_dit_trunk"


def rmsnorm(u, g):
    u32 = u.astype(jnp.float32)
    y = u32 * lax.rsqrt(jnp.mean(u32 * u32, axis=-1, keepdims=True) + EPS)
    return (y * g.astype(jnp.float32)).astype(u.dtype)


def modulation(cond, w_mod, b_mod):
    m = jax.nn.silu(cond) @ w_mod + b_mod
    shift, scale, gate = jnp.split(m, 3, axis=-1)
    if cond.ndim == 2:
        shift, scale, gate = shift[:, None, :], scale[:, None, :], gate[:, None, :]
    return shift, scale, gate


def split_proj(p):
    sizes = (D_ATTN, D_KV, D_KV, D_ATTN, D_LRU, D_LRU, 2 * D_MODEL)
    points = [sum(sizes[:i + 1]) for i in range(len(sizes) - 1)]
    return jnp.split(p, points, axis=-1)


def axial_rope(u, rows, cols):
    half = HEAD_DIM // 2
    quarter = half // 2
    freqs = ROPE_THETA ** (-jnp.arange(quarter, dtype=jnp.float32) / quarter)

    def rot(seg, pos):
        ang = pos.astype(jnp.float32)[:, None] * freqs
        cos = jnp.cos(ang)[None, :, None, :]
        sin = jnp.sin(ang)[None, :, None, :]
        s = seg.astype(jnp.float32)
        s1, s2 = s[..., :quarter], s[..., quarter:]
        return jnp.concatenate([s1 * cos - s2 * sin, s2 * cos + s1 * sin], axis=-1)

    out = jnp.concatenate([rot(u[..., :half], rows), rot(u[..., half:], cols)], axis=-1)
    return out.astype(u.dtype)


def gqa(q, k, v):
    s = jnp.einsum('bqkgd,bskd->bkgqs', q, k).astype(jnp.float32)
    p = jax.nn.softmax(s, axis=-1).astype(v.dtype)
    return jnp.einsum('bkgqs,bskd->bqkgd', p, v)


def latent_attention(q, k_all, v_all):
    B, n = q.shape[0], q.shape[1]
    nb = n // Q_BLOCK
    qb = q.reshape(B, nb, Q_BLOCK, N_KV_HEADS, Q_PER_KV, HEAD_DIM).swapaxes(0, 1)
    o = lax.map(lambda qblk: gqa(qblk, k_all, v_all), qb)
    return o.swapaxes(0, 1).reshape(B, n, D_ATTN)


def centred_conv(u, w, b):
    n = u.shape[1]
    up = jnp.pad(u, ((0, 0), (CONV_PAD_LEFT, CONV_W - 1 - CONV_PAD_LEFT), (0, 0)))
    out = up[:, 0:n] * w[0]
    for j in range(1, CONV_W):
        out = out + up[:, j:j + n] * w[j]
    return out + b


def block_diag(u, w):
    ub = u.reshape(u.shape[:-1] + (LRU_BLOCKS, LRU_BLOCK))
    return jnp.einsum('bnhi,hij->bnhj', ub, w).reshape(u.shape)


def lru_coeffs(u, w_gates, b_gates, lam):
    u32 = u.astype(jnp.float32)
    r = jax.nn.sigmoid(block_diag(u32, w_gates[0].astype(jnp.float32)) + b_gates[0].astype(jnp.float32))
    i = jax.nn.sigmoid(block_diag(u32, w_gates[1].astype(jnp.float32)) + b_gates[1].astype(jnp.float32))
    log_a = -LRU_C * r * jax.nn.softplus(-lam.astype(jnp.float32))
    a = jnp.exp(log_a)
    b = jnp.sqrt(-jnp.expm1(2.0 * log_a)) * (i * u32)
    return a, b


def _scan_combine(left, right):
    a1, b1 = left
    a2, b2 = right
    return a1 * a2, a2 * b1 + b2


def linear_scan(a, b, h0, reverse):
    if h0 is not None:
        idx = -1 if reverse else 0
        b = b.at[:, idx].add(a[:, idx] * h0)
    _, h = lax.associative_scan(_scan_combine, (a, b), reverse=reverse, axis=1)
    return h


def lru_branch(u_ctx, u_lat, conv_w, conv_b, w_gates, b_gates, lam, need_ctx):
    uc = centred_conv(u_ctx, conv_w, conv_b)
    ul = centred_conv(u_lat, conv_w, conv_b)
    h_ctx_dirs, h_lat_dirs = [], []
    for d, rev in enumerate((False, True)):
        a_c, b_c = lru_coeffs(uc, w_gates[d], b_gates[d], lam[d])
        h_c = linear_scan(a_c, b_c, None, rev)
        h_end = h_c[:, 0] if rev else h_c[:, -1]
        a_l, b_l = lru_coeffs(ul, w_gates[d], b_gates[d], lam[d])
        h_lat_dirs.append(linear_scan(a_l, b_l, h_end, rev))
        h_ctx_dirs.append(h_c)
    y_lat = (h_lat_dirs[0] + h_lat_dirs[1]).astype(u_lat.dtype)
    y_ctx = (h_ctx_dirs[0] + h_ctx_dirs[1]).astype(u_ctx.dtype) if need_ctx else None
    return y_ctx, y_lat


def merge_branches(o_attn, g_attn, o_lru, g_lru, g_merge, w_a_out, w_b_out, w_out):
    ya = (o_attn * jax.nn.silu(g_attn)) @ w_a_out
    yb = (o_lru * jax.nn.silu(g_lru)) @ w_b_out
    gma, gmb = jnp.split(g_merge, 2, axis=-1)
    return (jax.nn.sigmoid(gma) * ya + jax.nn.sigmoid(gmb) * yb) @ w_out


def setup_inputs(seed: int = 0) -> dict:
    key = jax.random.key(seed)
    ks = jax.random.split(key, 20)

    def nrm(k, shape, s):
        return jax.random.normal(k, shape, jnp.float32) * s

    a0 = jax.random.uniform(ks[14], (DEPTH, 2, D_LRU), jnp.float32, minval=0.9, maxval=0.999)
    return {
        "x": nrm(ks[0], (BATCH, SEQ, D_MODEL), 1.0),
        "c": nrm(ks[1], (BATCH, D_MODEL), 1.0),
        "ctx": nrm(ks[2], (BATCH, CTX_LEN, D_MODEL), 1.0),
        "c_ctx": nrm(ks[3], (D_MODEL,), 1.0),
        "norm_g": 1.0 + nrm(ks[4], (DEPTH, D_MODEL), 0.05),
        "w_mod": nrm(ks[5], (DEPTH, D_MODEL, 3 * D_MODEL), 0.5 * D_MODEL ** -0.5),
        "b_mod": nrm(ks[6], (DEPTH, 3 * D_MODEL), 0.01),
        "w_in": nrm(ks[7], (DEPTH, D_MODEL, D_IN), D_MODEL ** -0.5),
        "q_norm_g": 1.0 + nrm(ks[8], (DEPTH, HEAD_DIM), 0.05),
        "k_norm_g": 1.0 + nrm(ks[9], (DEPTH, HEAD_DIM), 0.05),
        "conv_w": nrm(ks[10], (DEPTH, CONV_W, D_LRU), CONV_W ** -0.5),
        "conv_b": nrm(ks[11], (DEPTH, D_LRU), 0.01),
        "lru_gate_w": nrm(ks[12], (DEPTH, 2, 2, LRU_BLOCKS, LRU_BLOCK, LRU_BLOCK), LRU_BLOCK ** -0.5),
        "lru_gate_b": nrm(ks[13], (DEPTH, 2, 2, D_LRU), 0.01),
        "lru_lambda": jnp.log(a0) - jnp.log1p(-a0),
        "w_a_out": nrm(ks[15], (DEPTH, D_ATTN, D_MODEL), D_ATTN ** -0.5),
        "w_b_out": nrm(ks[16], (DEPTH, D_LRU, D_MODEL), D_LRU ** -0.5),
        "w_out": nrm(ks[17], (DEPTH, D_MODEL, D_MODEL), D_MODEL ** -0.5),
    }


def reference(x, c, ctx, c_ctx, norm_g, w_mod, b_mod, w_in, q_norm_g, k_norm_g, conv_w, conv_b,
              lru_gate_w, lru_gate_b, lru_lambda, w_a_out, w_b_out, w_out):
    B, n, _ = x.shape
    L = ctx.shape[1]
    ROWS = n // GRID_W
    rows = jnp.broadcast_to(jnp.arange(ROWS)[:, None], (ROWS, GRID_W)).reshape(-1)
    cols = jnp.broadcast_to(jnp.arange(GRID_W)[None, :], (ROWS, GRID_W)).reshape(-1)
    scale = HEAD_DIM ** -0.5

    for l in range(DEPTH):
        need_ctx = l < DEPTH - 1
        sh_l, sc_l, gt_l = modulation(c, w_mod[l], b_mod[l])
        sh_c, sc_c, gt_c = modulation(c_ctx, w_mod[l], b_mod[l])
        h_lat = rmsnorm(x, norm_g[l]) * (1.0 + sc_l) + sh_l
        h_ctx = rmsnorm(ctx, norm_g[l]) * (1.0 + sc_c) + sh_c

        q_l, k_l, v_l, ga_l, u_l, gb_l, gm_l = split_proj(h_lat @ w_in[l])
        q_c, k_c, v_c, ga_c, u_c, gb_c, gm_c = split_proj(h_ctx @ w_in[l])

        q_l = axial_rope(rmsnorm(q_l.reshape(B, n, N_Q_HEADS, HEAD_DIM), q_norm_g[l]), rows, cols) * scale
        k_l = axial_rope(rmsnorm(k_l.reshape(B, n, N_KV_HEADS, HEAD_DIM), k_norm_g[l]), rows, cols)
        v_l = v_l.reshape(B, n, N_KV_HEADS, HEAD_DIM)
        k_c = rmsnorm(k_c.reshape(B, L, N_KV_HEADS, HEAD_DIM), k_norm_g[l])
        v_c = v_c.reshape(B, L, N_KV_HEADS, HEAD_DIM)
        k_all = jnp.concatenate([k_c, k_l], axis=1)
        v_all = jnp.concatenate([v_c, v_l], axis=1)
        o_lat = latent_attention(q_l, k_all, v_all)

        lru_c, lru_l = lru_branch(u_c, u_l, conv_w[l], conv_b[l], lru_gate_w[l], lru_gate_b[l],
                                  lru_lambda[l], need_ctx)

        x = x + gt_l * merge_branches(o_lat, ga_l, lru_l, gb_l, gm_l, w_a_out[l], w_b_out[l], w_out[l])

        if need_ctx:
            q_c = rmsnorm(q_c.reshape(B, L, N_Q_HEADS, HEAD_DIM), q_norm_g[l]) * scale
            o_ctx = gqa(q_c.reshape(B, L, N_KV_HEADS, Q_PER_KV, HEAD_DIM), k_c, v_c).reshape(B, L, D_ATTN)
            ctx = ctx + gt_c * merge_branches(o_ctx, ga_c, lru_c, gb_c, gm_c, w_a_out[l], w_b_out[l], w_out[l])

    return x
```

```cpp
#include <hip/hip_runtime.h>
#include <hip/hip_cooperative_groups.h>
#include <stdint.h>
#include <stdio.h>
namespace cg = cooperative_groups;

#ifndef MULTI
#define MULTI 0
#endif

#ifndef DUPMASK
#define DUPMASK 0
#endif
#define DI __device__ __forceinline__
typedef unsigned short bf16_t;
typedef __attribute__((ext_vector_type(8))) short bf16x8;
typedef __attribute__((ext_vector_type(4))) short s16x4;
typedef __attribute__((ext_vector_type(4))) float f32x4;
typedef __attribute__((ext_vector_type(16))) float f32x16;

constexpr int DM = 1024;
constexpr int NBATCH = 4;
constexpr int SEQ = 4096;
constexpr int CTXL = 256;
constexpr int TOK = SEQ + CTXL;
constexpr int MALL = NBATCH * TOK;
constexpr int MHALF = MALL / 2;
constexpr int DIN = 6656;
constexpr int HP = 1024;
constexpr int C_Q = 0, C_K = 1024, C_V = 1280, C_GA = 1536, C_U = 2560, C_GB = 3584, C_GM = 4608;
constexpr int NCHUNK = TOK / 64;
constexpr int SMEM_BYTES = 73728;
constexpr int NPH = 2 + 6 * 4;

struct Params {
  const float* x; const float* c; const float* ctx; const float* c_ctx; const float* norm_g; const float* w_mod;
  const float* b_mod; const float* w_in; const float* q_norm_g; const float* k_norm_g; const float* conv_w;
  const float* conv_b; const float* gate_w; const float* gate_b; const float* lam; const float* w_a; const float* w_b;
  const float* w_o;
  float* out;
  bf16_t* P;
  bf16_t* Hs;
  float* agg;
  bf16_t* Wt_in;
  bf16_t* Wt_abo;
  float* Xctx;
  float* mod;
  float* rope;
  bf16_t* Wg;
  float* modp;
  bf16_t* lab;
  unsigned* bar;
};

typedef float f32x2_t __attribute__((ext_vector_type(2)));
typedef __bf16 bf16x2_t __attribute__((ext_vector_type(2)));
DI unsigned pack2(float a, float b) { f32x2_t v = {a, b}; bf16x2_t r = __builtin_convertvector(v, bf16x2_t); return __builtin_bit_cast(unsigned, r); }
DI unsigned f2bf(float x) { return pack2(x, 0.f) & 0xffffu; }
DI float bflo(unsigned u) { return __uint_as_float(u << 16); }
DI float bfhi(unsigned u) { return __uint_as_float(u & 0xffff0000u); }
DI float bf2f(bf16_t b) { return __uint_as_float(((unsigned)b) << 16); }
DI float sigm(float x) { return __builtin_amdgcn_rcpf(1.f + __builtin_amdgcn_exp2f(-1.4426950408889634f * x)); }
DI float silu(float x) { return x * sigm(x); }
DI f32x4 mfma16(bf16x8 a, bf16x8 b, f32x4 c) { return __builtin_amdgcn_mfma_f32_16x16x32_bf16(a, b, c, 0, 0, 0); }
DI f32x16 mfma32(bf16x8 a, bf16x8 b, f32x16 c) { return __builtin_amdgcn_mfma_f32_32x32x16_bf16(a, b, c, 0, 0, 0); }

DI int opaque_tid() { int t = threadIdx.x; asm volatile("" : "+v"(t)); return t; }

DI const float* xrow(const Params& p, int l, int b, int t) {
  if (t < CTXL) return (l == 0 ? p.ctx : (const float*)p.Xctx) + (size_t)(b * CTXL + t) * DM;
  return (l == 0 ? p.x : (const float*)p.out) + (size_t)(b * SEQ + (t - CTXL)) * DM;
}

DI void mod_partial_item(const Params& p, int item, char* smem) {
  float* sc = (float*)smem;
  float* red = sc + 320;
  const int l = item / 192, rem = item % 192, cc = rem >> 4, kc = rem & 15;
  const int tid = opaque_tid(), w = tid >> 6, lane = tid & 63;
  for (int i = tid; i < 320; i += 256) {
    const int s = i >> 6, k = kc * 64 + (i & 63);
    const float v = (s < 4) ? p.c[s * 1024 + k] : p.c_ctx[k];
    sc[i] = silu(v);
  }
  __syncthreads();
  const float* wp = p.w_mod + ((size_t)l * 1024 + kc * 64 + w * 16) * 3072 + cc * 256 + lane * 4;
  float4 wv[16];
#pragma unroll
  for (int i = 0; i < 16; ++i) wv[i] = *(const float4*)(wp + (size_t)i * 3072);
  float4 acc[5];
#pragma unroll
  for (int s = 0; s < 5; ++s) acc[s] = float4{0.f, 0.f, 0.f, 0.f};
#pragma unroll
  for (int i = 0; i < 16; ++i) {
#pragma unroll
    for (int s = 0; s < 5; ++s) {
      const float cv = sc[s * 64 + w * 16 + i];
      acc[s].x += cv * wv[i].x; acc[s].y += cv * wv[i].y; acc[s].z += cv * wv[i].z; acc[s].w += cv * wv[i].w;
    }
  }
#pragma unroll
  for (int s = 0; s < 5; ++s) *(float4*)(red + (w * 5 + s) * 256 + lane * 4) = acc[s];
  __syncthreads();
  {
    const int col = tid;
#pragma unroll
    for (int s = 0; s < 5; ++s) {
      const float v = red[(0 * 5 + s) * 256 + col] + red[(1 * 5 + s) * 256 + col] + red[(2 * 5 + s) * 256 + col] + red[(3 * 5 + s) * 256 + col];
      p.modp[(size_t)kc * 61440 + (size_t)(l * 5 + s) * 3072 + cc * 256 + col] = v;
    }
  }
  __syncthreads();
}

DI void mod_reduce_item(const Params& p, int item) {
  const int idx = item * 256 + opaque_tid();
  const int n = idx % 3072, l = idx / (5 * 3072);
  float v = p.b_mod[l * 3072 + n];
#pragma unroll
  for (int kc = 0; kc < 16; ++kc) v += p.modp[(size_t)kc * 61440 + idx];
  p.mod[idx] = v;
}

DI void rope_item(const Params& p) {
  for (int idx = opaque_tid(); idx < 1024; idx += 256) {
    int pos = idx >> 4, i = idx & 15;
    float freq = exp2f(-(float)i * (13.287712379549449f / 16.f));
    float ang = (float)pos * freq;
    float rev = ang * 0.15915494309189535f;
    rev -= floorf(rev);
    p.rope[idx * 2 + 0] = __builtin_amdgcn_cosf(rev);
    p.rope[idx * 2 + 1] = __builtin_amdgcn_sinf(rev);
  }
}

DI void transpose_tile(const float* __restrict__ src, int R, int C, bf16_t* __restrict__ dst, int dp, int r0, int c0, char* smem) {
  float (*tl)[65] = (float (*)[65])smem;
  const int tid = opaque_tid();
#pragma unroll
  for (int i = 0; i < 4; ++i) {
    int r = (tid >> 4) + 16 * i, c = (tid & 15) * 4;
    float4 v = *(const float4*)(src + (size_t)(r0 + r) * C + c0 + c);
    tl[r][c] = v.x; tl[r][c + 1] = v.y; tl[r][c + 2] = v.z; tl[r][c + 3] = v.w;
  }
  __syncthreads();
#pragma unroll
  for (int i = 0; i < 2; ++i) {
    int n = (tid >> 3) + 32 * i, k8 = (tid & 7) * 8;
    uint4 o;
    o.x = pack2(tl[k8][n], tl[k8 + 1][n]); o.y = pack2(tl[k8 + 2][n], tl[k8 + 3][n]);
    o.z = pack2(tl[k8 + 4][n], tl[k8 + 5][n]); o.w = pack2(tl[k8 + 6][n], tl[k8 + 7][n]);
    *(uint4*)(dst + (size_t)(c0 + n) * dp + r0 + k8) = o;
  }
  __syncthreads();
}

DI void norm_item(const Params& p, int l, int item) {
  const int tid = opaque_tid(); const int w = tid >> 6, lane = tid & 63;
  const int m = item * 4 + w;
  const int b = m / TOK, t = m % TOK;
  const float* src = xrow(p, l, b, t);
  const int s = (t < CTXL) ? 4 : b;
  const float* md = p.mod + (size_t)(l * 5 + s) * 3072;
  const float* g = p.norm_g + l * 1024;
  float4 v[4];
  float ss = 0.f;
#pragma unroll
  for (int i = 0; i < 4; ++i) {
    v[i] = *(const float4*)(src + (i * 64 + lane) * 4);
    ss += v[i].x * v[i].x + v[i].y * v[i].y + v[i].z * v[i].z + v[i].w * v[i].w;
  }
#pragma unroll
  for (int off = 32; off >= 1; off >>= 1) ss += __shfl_xor(ss, off);
  const float rstd = rsqrtf(ss * (1.f / 1024.f) + 1e-6f);
  bf16_t* dst = p.Hs + (size_t)m * HP;
#pragma unroll
  for (int i = 0; i < 4; ++i) {
    int k = (i * 64 + lane) * 4;
    float4 gg = *(const float4*)(g + k), sh = *(const float4*)(md + k), scl = *(const float4*)(md + 1024 + k);
    float h0 = v[i].x * rstd * gg.x * (1.f + scl.x) + sh.x;
    float h1 = v[i].y * rstd * gg.y * (1.f + scl.y) + sh.y;
    float h2 = v[i].z * rstd * gg.z * (1.f + scl.z) + sh.z;
    float h3 = v[i].w * rstd * gg.w * (1.f + scl.w) + sh.w;
    uint2 o; o.x = pack2(h0, h1); o.y = pack2(h2, h3);
    *(uint2*)(dst + k) = o;
  }
}

DI void norm_run(const Params& p, int l, int i0, int nb, int n_items) {
  if (i0 >= n_items) return;
  const int tid = opaque_tid(); const int w = tid >> 6, lane = tid & 63;
  const float* g = p.norm_g + l * 1024;
  float4 gg[4];
#pragma unroll
  for (int i = 0; i < 4; ++i) gg[i] = *(const float4*)(g + (i * 64 + lane) * 4);
  float4 v[4], vn[4];
  {
    const int m = i0 * 4 + w;
    const float* src = xrow(p, l, m / TOK, m % TOK);
#pragma unroll
    for (int i = 0; i < 4; ++i) v[i] = *(const float4*)(src + (i * 64 + lane) * 4);
  }
  for (int it = i0; it < n_items; it += nb) {
    const int m = it * 4 + w;
    const int b = m / TOK, t = m % TOK;
    const bool more = it + nb < n_items;
    if (more) {
      const int m2 = (it + nb) * 4 + w;
      const float* src2 = xrow(p, l, m2 / TOK, m2 % TOK);
#pragma unroll
      for (int i = 0; i < 4; ++i) vn[i] = *(const float4*)(src2 + (i * 64 + lane) * 4);
    }
    const float* md = p.mod + (size_t)(l * 5 + ((t < CTXL) ? 4 : b)) * 3072;
    float ss = 0.f;
#pragma unroll
    for (int i = 0; i < 4; ++i) ss += v[i].x * v[i].x + v[i].y * v[i].y + v[i].z * v[i].z + v[i].w * v[i].w;
#pragma unroll
    for (int off = 32; off >= 1; off >>= 1) ss += __shfl_xor(ss, off);
    const float rstd = rsqrtf(ss * (1.f / 1024.f) + 1e-6f);
    bf16_t* dst = p.Hs + (size_t)m * HP;
#pragma unroll
    for (int i = 0; i < 4; ++i) {
      const int k = (i * 64 + lane) * 4;
      const float4 sh = *(const float4*)(md + k), scl = *(const float4*)(md + 1024 + k);
      const float h0 = v[i].x * rstd * gg[i].x * (1.f + scl.x) + sh.x;
      const float h1 = v[i].y * rstd * gg[i].y * (1.f + scl.y) + sh.y;
      const float h2 = v[i].z * rstd * gg[i].z * (1.f + scl.z) + sh.z;
      const float h3 = v[i].w * rstd * gg[i].w * (1.f + scl.w) + sh.w;
      uint2 o; o.x = pack2(h0, h1); o.y = pack2(h2, h3);
      *(uint2*)(dst + k) = o;
    }
    if (more) {
#pragma unroll
      for (int i = 0; i < 4; ++i) v[i] = vn[i];
    }
  }
}

template <int KK0, int KK1>
DI void gemm_compute(const bf16_t (*As)[128][64], const bf16_t (*Bs)[128][64], int cur, int wm, int wn, int fr, int fq,
                     f32x4 (&acc)[4][4]) {
  const int sw = (fr >> 1) & 7;
#pragma unroll
  for (int kk = KK0; kk < KK1; ++kk) {
    bf16x8 af[4], bfr[4];
#pragma unroll
    for (int i = 0; i < 4; ++i) af[i] = *(const bf16x8*)&As[cur][64 * wm + 16 * i + fr][((4 * kk + fq) ^ sw) * 8];
#pragma unroll
    for (int j = 0; j < 4; ++j) bfr[j] = *(const bf16x8*)&Bs[cur][64 * wn + 16 * j + fr][((4 * kk + fq) ^ sw) * 8];
#pragma unroll
    for (int i = 0; i < 4; ++i)
#pragma unroll
      for (int j = 0; j < 4; ++j) acc[i][j] = mfma16(bfr[j], af[i], acc[i][j]);
  }
}

DI void gemm_mainloop(const bf16_t* __restrict__ A, int lda, const bf16_t* __restrict__ Bt, int ldb, int m0, int n0, int K,
                      f32x4 (&acc)[4][4], char* smem, bool primed = false, const bf16_t* nA = nullptr, int nm0 = 0,
                      const bf16_t* nB = nullptr, int nn0 = 0) {
  typedef bf16_t (*tile_t)[128][64];
  tile_t As = (tile_t)smem;
  tile_t Bs = (tile_t)(smem + 2 * 128 * 64 * 2);
  const int tid = opaque_tid(), w = tid >> 6, lane = tid & 63, wm = w >> 1, wn = w & 1;
  const int fr = lane & 15, fq = lane >> 4;
  const int lrow = lane >> 3;
  const int ce = ((lane & 7) ^ (lane >> 4)) * 8;
  const int co = ((lane & 7) ^ (4 + (lane >> 4))) * 8;
  const bf16_t* ap0 = A + (size_t)(m0 + 32 * w + lrow) * lda;
  const bf16_t* bp0 = Bt + (size_t)(n0 + 32 * w + lrow) * ldb;
  const bf16_t* ap[4] = {ap0 + ce, ap0 + (size_t)8 * lda + co, ap0 + (size_t)16 * lda + ce, ap0 + (size_t)24 * lda + co};
  const bf16_t* bp[4] = {bp0 + ce, bp0 + (size_t)8 * ldb + co, bp0 + (size_t)16 * ldb + ce, bp0 + (size_t)24 * ldb + co};
#define GLDS1(BUF, KT, I) \
  __builtin_amdgcn_global_load_lds((const unsigned*)(ap[I] + (KT) * 64), (unsigned*)&As[BUF][32 * w + 8 * (I)][0], 16, 0, 0); \
  __builtin_amdgcn_global_load_lds((const unsigned*)(bp[I] + (KT) * 64), (unsigned*)&Bs[BUF][32 * w + 8 * (I)][0], 16, 0, 0);
#define GLDS(BUF, KT) { GLDS1(BUF, KT, 0) GLDS1(BUF, KT, 1) GLDS1(BUF, KT, 2) GLDS1(BUF, KT, 3) }
  const int nt = K >> 6;
  if (!primed) {
    GLDS(0, 0)
    GLDS(1, 1)
  }
  const bool hasnext = nA != nullptr;
  const int sw = (fr >> 1) & 7;
#define NGLDS(BUF) { \
    const bf16_t* na0 = nA + (size_t)(nm0 + 32 * w + lrow) * lda + (BUF) * 64; \
    const bf16_t* nb0 = nB + (size_t)(nn0 + 32 * w + lrow) * ldb + (BUF) * 64; \
    __builtin_amdgcn_global_load_lds((const unsigned*)(na0 + ce), (unsigned*)&As[BUF][32 * w + 0][0], 16, 0, 0); \
    __builtin_amdgcn_global_load_lds((const unsigned*)(nb0 + ce), (unsigned*)&Bs[BUF][32 * w + 0][0], 16, 0, 0); \
    __builtin_amdgcn_global_load_lds((const unsigned*)(na0 + (size_t)8 * lda + co), (unsigned*)&As[BUF][32 * w + 8][0], 16, 0, 0); \
    __builtin_amdgcn_global_load_lds((const unsigned*)(nb0 + (size_t)8 * ldb + co), (unsigned*)&Bs[BUF][32 * w + 8][0], 16, 0, 0); \
    __builtin_amdgcn_global_load_lds((const unsigned*)(na0 + (size_t)16 * lda + ce), (unsigned*)&As[BUF][32 * w + 16][0], 16, 0, 0); \
    __builtin_amdgcn_global_load_lds((const unsigned*)(nb0 + (size_t)16 * ldb + ce), (unsigned*)&Bs[BUF][32 * w + 16][0], 16, 0, 0); \
    __builtin_amdgcn_global_load_lds((const unsigned*)(na0 + (size_t)24 * lda + co), (unsigned*)&As[BUF][32 * w + 24][0], 16, 0, 0); \
    __builtin_amdgcn_global_load_lds((const unsigned*)(nb0 + (size_t)24 * ldb + co), (unsigned*)&Bs[BUF][32 * w + 24][0], 16, 0, 0); }
#define GTILE(BUF, KT2, MORE)                                                                                         \
  {                                                                                                                   \
    bf16x8 a0[4], b0[4], a1[4], b1[4];                                                                                \
    const int pc0 = ((0 + fq) ^ sw) * 8, pc1 = ((4 + fq) ^ sw) * 8;                                                   \
    _Pragma("unroll") for (int i = 0; i < 4; ++i) a0[i] = *(const bf16x8*)&As[BUF][64 * wm + 16 * i + fr][pc0];       \
    _Pragma("unroll") for (int j = 0; j < 4; ++j) b0[j] = *(const bf16x8*)&Bs[BUF][64 * wn + 16 * j + fr][pc0];       \
    _Pragma("unroll") for (int i = 0; i < 4; ++i) a1[i] = *(const bf16x8*)&As[BUF][64 * wm + 16 * i + fr][pc1];       \
    _Pragma("unroll") for (int j = 0; j < 4; ++j) b1[j] = *(const bf16x8*)&Bs[BUF][64 * wn + 16 * j + fr][pc1];       \
    asm volatile("s_waitcnt lgkmcnt(0)" ::: "memory");                                                                \
    __builtin_amdgcn_s_barrier();                              \
    if (MORE) GLDS(BUF, KT2) else if (hasnext) NGLDS(BUF)                                                             \
    _Pragma("unroll") for (int i = 0; i < 4; ++i)                                                                     \
      _Pragma("unroll") for (int j = 0; j < 4; ++j) acc[i][j] = mfma16(b0[j], a0[i], acc[i][j]);                      \
    _Pragma("unroll") for (int i = 0; i < 4; ++i)                                                                     \
      _Pragma("unroll") for (int j = 0; j < 4; ++j) acc[i][j] = mfma16(b1[j], a1[i], acc[i][j]);                      \
  }
  for (int t = 0; t < nt; t += 2) {
    const bool more = t + 2 < nt;
    asm volatile("s_waitcnt vmcnt(8)" ::: "memory");
    __builtin_amdgcn_s_barrier();
    GTILE(0, t + 2, more)
    if (more || hasnext) asm volatile("s_waitcnt vmcnt(8)" ::: "memory"); else asm volatile("s_waitcnt vmcnt(0)" ::: "memory");
    __builtin_amdgcn_s_barrier();
    GTILE(1, t + 3, more)
  }
#undef GTILE
#undef NGLDS
#undef GLDS
#undef GLDS1
}

DI void zero_acc(f32x4 (&acc)[4][4]) {
#pragma unroll
  for (int i = 0; i < 4; ++i)
#pragma unroll
    for (int j = 0; j < 4; ++j) acc[i][j] = f32x4{0.f, 0.f, 0.f, 0.f};
}

DI void g1_tile(const Params& p, int item, char* smem, bool primed = false, int next_item = -1) {
  const int mt = item / 52, nt = item % 52;
  const bf16_t* A = p.Hs;
  f32x4 acc[4][4];
  zero_acc(acc);
  if (next_item >= 0)
    gemm_mainloop(A, HP, p.Wt_in, HP, mt * 128, nt * 128, 1024, acc, smem, primed, A, (next_item / 52) * 128, p.Wt_in, (next_item % 52) * 128);
  else
    gemm_mainloop(A, HP, p.Wt_in, HP, mt * 128, nt * 128, 1024, acc, smem, primed);
  const int tid = opaque_tid(), w = tid >> 6, lane = tid & 63, wm = w >> 1, wn = w & 1;
  const int mbase = mt * 128 + 64 * wm + (lane & 15);
  const int nbase = nt * 128 + 64 * wn + 4 * (lane >> 4);
#pragma unroll
  for (int i = 0; i < 4; ++i)
#pragma unroll
    for (int j = 0; j < 4; ++j) {
      uint2 o; o.x = pack2(acc[i][j][0], acc[i][j][1]); o.y = pack2(acc[i][j][2], acc[i][j][3]);
      *(uint2*)(p.P + (size_t)(mbase + 16 * i) * DIN + nbase + 16 * j) = o;
    }
}

DI void g2_tile(const Params& p, int mt, int nt, char* smem, bool dry, bool primed = false, int nmt = -1, int nnt = 0) {
  f32x4 acc[4][4];
  const int tid = opaque_tid(), w = tid >> 6, lane = tid & 63, wm = w >> 1, wn = w & 1;
  const int mbase = mt * 128 + 64 * wm + (lane & 15);
  const int nbase = nt * 128 + 64 * wn + 4 * (lane >> 4);
  zero_acc(acc);
  gemm_mainloop(p.P + C_Q, DIN, p.Wt_abo, HP, mt * 128, nt * 128, 1024, acc, smem, primed, p.P + C_GB, mt * 128, p.Wt_abo + 1024 * HP, nt * 128);
#pragma unroll
  for (int i = 0; i < 4; ++i)
#pragma unroll
    for (int j = 0; j < 4; ++j) {
      bf16_t* pr = p.P + (size_t)(mbase + 16 * i) * DIN + C_GM + nbase + 16 * j;
      uint2 g = *(const uint2*)pr;
      uint2 o;
      o.x = pack2(acc[i][j][0] * sigm(bflo(g.x)), acc[i][j][1] * sigm(bfhi(g.x)));
      o.y = pack2(acc[i][j][2] * sigm(bflo(g.y)), acc[i][j][3] * sigm(bfhi(g.y)));
      if (!dry) *(uint2*)pr = o;
    }
  zero_acc(acc);
  if (nmt >= 0)
    gemm_mainloop(p.P + C_GB, DIN, p.Wt_abo + 1024 * HP, HP, mt * 128, nt * 128, 1024, acc, smem, true, p.P + C_Q, nmt * 128, p.Wt_abo, nnt * 128);
  else
    gemm_mainloop(p.P + C_GB, DIN, p.Wt_abo + 1024 * HP, HP, mt * 128, nt * 128, 1024, acc, smem, true);
#pragma unroll
  for (int i = 0; i < 4; ++i)
#pragma unroll
    for (int j = 0; j < 4; ++j) {
      bf16_t* pr = p.P + (size_t)(mbase + 16 * i) * DIN + C_GM + nbase + 16 * j;
      uint2 g = *(const uint2*)(pr + 1024);
      uint2 zp = *(const uint2*)pr;
      float z0 = bflo(zp.x) + acc[i][j][0] * sigm(bflo(g.x)), z1 = bfhi(zp.x) + acc[i][j][1] * sigm(bfhi(g.x));
      float z2 = bflo(zp.y) + acc[i][j][2] * sigm(bflo(g.y)), z3 = bfhi(zp.y) + acc[i][j][3] * sigm(bfhi(g.y));
      uint2 o; o.x = pack2(z0, z1); o.y = pack2(z2, z3);
      if (!dry) *(uint2*)pr = o;
    }
}

DI void g3_tile(const Params& p, int l, int mt, int nt, char* smem, bool dry, bool primed = false, int nmt = -1, int nnt = 0) {
  f32x4 acc[4][4];
  zero_acc(acc);
  if (nmt >= 0)
    gemm_mainloop(p.P + C_GM, DIN, p.Wt_abo + 2 * 1024 * HP, HP, mt * 128, nt * 128, 1024, acc, smem, primed, p.P + C_GM, nmt * 128, p.Wt_abo + 2 * 1024 * HP, nnt * 128);
  else
    gemm_mainloop(p.P + C_GM, DIN, p.Wt_abo + 2 * 1024 * HP, HP, mt * 128, nt * 128, 1024, acc, smem, primed);
  const int tid = opaque_tid(), w = tid >> 6, lane = tid & 63, wm = w >> 1, wn = w & 1;
  const int mbase = mt * 128 + 64 * wm + (lane & 15);
  const int nbase = nt * 128 + 64 * wn + 4 * (lane >> 4);
  const int b = (mt * 128) / TOK;
  const int tt0 = (mt * 128) % TOK;
  const int s = (tt0 < CTXL) ? 4 : b;
  const float* gt = p.mod + (size_t)(l * 5 + s) * 3072 + 2048;
#pragma unroll
  for (int i = 0; i < 4; ++i) {
    const int m = mbase + 16 * i;
    const int t = m - b * TOK;
    const float* xs = xrow(p, l, b, t);
    float* xd = (t < CTXL) ? (p.Xctx + (size_t)(b * CTXL + t) * DM) : (p.out + (size_t)(b * SEQ + (t - CTXL)) * DM);
#pragma unroll
    for (int j = 0; j < 4; ++j) {
      const int n = nbase + 16 * j;
      float4 xv = *(const float4*)(xs + n);
      float4 gv = *(const float4*)(gt + n);
      float4 o;
      o.x = xv.x + gv.x * acc[i][j][0]; o.y = xv.y + gv.y * acc[i][j][1];
      o.z = xv.z + gv.z * acc[i][j][2]; o.w = xv.w + gv.w * acc[i][j][3];
      if (!dry) *(float4*)(xd + n) = o;
    }
  }
}

DI void qk_finish(const uint2 (&u)[4], bf16_t* base, const float* g, const float* rope, bool lat, int rowp, int colp, int j4,
                  float sc, bool dry) {
  float v[4][4];
  float ss = 0.f;
#pragma unroll
  for (int qq = 0; qq < 4; ++qq) {
    v[qq][0] = bflo(u[qq].x); v[qq][1] = bfhi(u[qq].x); v[qq][2] = bflo(u[qq].y); v[qq][3] = bfhi(u[qq].y);
    ss += v[qq][0] * v[qq][0] + v[qq][1] * v[qq][1] + v[qq][2] * v[qq][2] + v[qq][3] * v[qq][3];
  }
  ss += __shfl_xor(ss, 1);
  ss += __shfl_xor(ss, 2);
  const float rstd = rsqrtf(ss * (1.f / 64.f) + 1e-6f);
#pragma unroll
  for (int qq = 0; qq < 4; ++qq)
#pragma unroll
    for (int e = 0; e < 4; ++e) v[qq][e] = v[qq][e] * rstd * g[16 * qq + e];
  if (lat) {
#pragma unroll
    for (int e = 0; e < 4; ++e) {
      const int fi = 4 * j4 + e;
      float2 cr = *(const float2*)(rope + (rowp * 16 + fi) * 2);
      float2 cc = *(const float2*)(rope + (colp * 16 + fi) * 2);
      float a0 = v[0][e], a1 = v[1][e], a2 = v[2][e], a3 = v[3][e];
      v[0][e] = a0 * cr.x - a1 * cr.y; v[1][e] = a1 * cr.x + a0 * cr.y;
      v[2][e] = a2 * cc.x - a3 * cc.y; v[3][e] = a3 * cc.x + a2 * cc.y;
    }
  }
#pragma unroll
  for (int qq = 0; qq < 4; ++qq) {
    uint2 o; o.x = pack2(v[qq][0] * sc, v[qq][1] * sc); o.y = pack2(v[qq][2] * sc, v[qq][3] * sc);
    if (!dry) *(uint2*)(base + 16 * qq) = o;
  }
}

DI void qk_item(const Params& p, int l, int tile, bool dry) {
  const int tid = opaque_tid(), w = tid >> 6, lane = tid & 63;
  const int m0 = tile * 32;
  const int t0 = m0 % TOK;
  const int hd = lane >> 2, j4 = lane & 3;
  const float* gq = p.q_norm_g + l * 64 + 4 * j4;
  const float* gk = p.k_norm_g + l * 64 + 4 * j4;
  for (int tt = 0; tt < 8; tt += 2) {
    uint2 uq[2][4], uk[2][4];
#pragma unroll
    for (int x = 0; x < 2; ++x) {
      const size_t m = (size_t)m0 + 8 * w + tt + x;
      const bf16_t* qb = p.P + m * DIN + C_Q + hd * 64 + 4 * j4;
      const bf16_t* kb = p.P + m * DIN + C_K + (hd & 3) * 64 + 4 * j4;
#pragma unroll
      for (int qq = 0; qq < 4; ++qq) { uq[x][qq] = *(const uint2*)(qb + 16 * qq); uk[x][qq] = *(const uint2*)(kb + 16 * qq); }
    }
#pragma unroll
    for (int x = 0; x < 2; ++x) {
      const int tok = 8 * w + tt + x;
      const size_t m = (size_t)m0 + tok;
      const int t = t0 + tok;
      const bool lat = t >= CTXL;
      const int nn = t - CTXL;
      const int rowp = (nn >> 6) & 63, colp = nn & 63;
      qk_finish(uq[x], p.P + m * DIN + C_Q + hd * 64 + 4 * j4, gq, p.rope, lat, rowp, colp, j4, 0.125f * 1.4426950408889634f, dry);
      if (lane < 16) qk_finish(uk[x], p.P + m * DIN + C_K + hd * 64 + 4 * j4, gk, p.rope, lat, rowp, colp, j4, 1.f, dry);
    }
  }
}

DI void vt_item(const Params& p, int tile, char* smem, bool dry) {
  const int tid = opaque_tid();
  const int m0 = tile * 64;
  bf16_t* vs = (bf16_t*)smem;
#pragma unroll
  for (int i = 0; i < 8; ++i) {
    int c = tid + 256 * i;
    int tok = c >> 5, cc = c & 31;
    uint4 v = *(const uint4*)(p.P + (size_t)(m0 + tok) * DIN + C_V + cc * 8);
    *(uint4*)(vs + tok * 264 + cc * 8) = v;
  }
  __syncthreads();
  {
    const int R = tid;
    bf16_t* dst = p.P + (size_t)(m0 + (R >> 2)) * DIN + C_V + (R & 3) * 64;
#pragma unroll
    for (int c8 = 0; c8 < 8; ++c8) {
      uint4 o;
      const int sa = (2 * c8) & 3, sb = (2 * c8 + 1) & 3;
      const int ta = ((c8 * 8) & ~12) | ((sa == 1 ? 2 : (sa == 2 ? 1 : sa)) << 2);
      const int tb = ((c8 * 8 + 4) & ~12) | ((sb == 1 ? 2 : (sb == 2 ? 1 : sb)) << 2);
      unsigned e0 = vs[(ta + 0) * 264 + R], e1 = vs[(ta + 1) * 264 + R], e2 = vs[(ta + 2) * 264 + R], e3 = vs[(ta + 3) * 264 + R];
      unsigned e4 = vs[(tb + 0) * 264 + R], e5 = vs[(tb + 1) * 264 + R], e6 = vs[(tb + 2) * 264 + R], e7 = vs[(tb + 3) * 264 + R];
      o.x = e0 | (e1 << 16); o.y = e2 | (e3 << 16); o.z = e4 | (e5 << 16); o.w = e6 | (e7 << 16);
      if (!dry) *(uint4*)(dst + c8 * 8) = o;
    }
  }
  __syncthreads();
}

DI float fold_range(const float2* ag, int first, int count, int step, float h) {
  for (int base = 0; base < count; base += 16) {
    float2 v[16];
#pragma unroll
    for (int i = 0; i < 16; ++i) {
      const int k = base + i;
      const int c = first + step * (k < count ? k : count - 1);
      v[i] = ag[(size_t)c * 1024];
    }
#pragma unroll
    for (int i = 0; i < 16; ++i) if (base + i < count) h = v[i].x * h + v[i].y;
  }
  return h;
}

DI void lru_item(const Params& p, int l, int b, int chunk, int blk, int pass, char* smem, bool dry) {
  const int item_index = (b * NCHUNK + chunk) * 16 + blk;
  float* ucf = (float*)smem;
  bf16_t* ucb = (bf16_t*)(smem + 16384);
  bf16_t* us = (bf16_t*)(smem + 25600);
  float* ybuf = (float*)(smem + 34304);
  const int tid = opaque_tid(), w = tid >> 6, lane = tid & 63, r = lane & 31, hh = lane >> 5;
  const int t0 = chunk * 64;
  const size_t rowbase = (size_t)b * TOK;
  const int seg_lo = (t0 < CTXL) ? 0 : CTXL, seg_hi = (t0 < CTXL) ? CTXL : TOK;
  const int dir = w >> 1, chh = w & 1;
  const int jj = 32 * chh + r;
  const int gch = blk * 64 + jj;

  float hin = 0.f;
  if (pass == 2) {
    const float2* ag = (const float2*)p.agg + ((size_t)(b * 2 + dir) * NCHUNK) * 1024 + gch;
    if (dir == 0) {
      hin = fold_range(ag, 0, chunk, 1, hin);
    } else if (chunk < 4) {
      hin = fold_range(ag, 3, 3 - chunk, -1, hin);
    } else {
      hin = fold_range(ag, 3, 4, -1, hin);
      hin = fold_range(ag, NCHUNK - 1, NCHUNK - 1 - chunk, -1, hin);
    }
  }
  f32x16 ar[2], ai[2];
#pragma unroll
  for (int T = 0; T < 2; ++T)
#pragma unroll
    for (int i = 0; i < 16; ++i) { ar[T][i] = 0.f; ai[T][i] = 0.f; }
  bf16_t* labp = p.lab + (size_t)item_index * 16384 + dir * 8192 + jj * 64;
  if (pass == 1) {
    bf16x8 wbr[4], wbi[4];
    {
      const bf16_t* gw = p.Wg + (size_t)((dir * 2 + 0) * 16 + blk) * 4096 + jj * 64 + 8 * hh;
  #pragma unroll
      for (int s = 0; s < 4; ++s) { wbr[s] = *(const bf16x8*)(gw + 16 * s); wbi[s] = *(const bf16x8*)(gw + 16 * 4096 + 16 * s); }
    }
    const float brr = p.gate_b[((l * 2 + dir) * 2 + 0) * 1024 + gch];
    const float bii = p.gate_b[((l * 2 + dir) * 2 + 1) * 1024 + gch];
    const float xl = -p.lam[(l * 2 + dir) * 1024 + gch];

    for (int c = tid; c < 67 * 8; c += 256) {
      int rr = c >> 3, kc = c & 7;
      int t = t0 - 2 + rr;
      uint4 v = uint4{0u, 0u, 0u, 0u};
      if (t >= seg_lo && t < seg_hi) v = *(const uint4*)(p.P + (rowbase + t) * DIN + C_U + blk * 64 + kc * 8);
      *(uint4*)(us + rr * 64 + kc * 8) = v;
    }
    __syncthreads();
    {
      const int ch = tid & 63, tg = tid >> 6;
      const float* cw = p.conv_w + (size_t)l * 4 * 1024 + blk * 64 + ch;
      const float w0 = cw[0], w1 = cw[1024], w2 = cw[2048], w3 = cw[3072];
      const float cb = p.conv_b[l * 1024 + blk * 64 + ch];
      float x0 = bf2f(us[(16 * tg + 0) * 64 + ch]), x1 = bf2f(us[(16 * tg + 1) * 64 + ch]), x2 = bf2f(us[(16 * tg + 2) * 64 + ch]);
  #pragma unroll
      for (int i = 0; i < 16; ++i) {
        float x3 = bf2f(us[(16 * tg + i + 3) * 64 + ch]);
        float o = x0 * w0;
        o += x1 * w1; o += x2 * w2; o += x3 * w3; o += cb;
        const int tok = 16 * tg + i;
        ucf[tok * 64 + ch] = o;
        ucb[tok * 72 + ch] = (bf16_t)f2bf(o);
        x0 = x1; x1 = x2; x2 = x3;
      }
    }
    __syncthreads();
    {
  #pragma unroll
      for (int s = 0; s < 4; ++s) {
        const bf16x8 br = wbr[s];
        const bf16x8 bi = wbi[s];
  #pragma unroll
        for (int T = 0; T < 2; ++T) {
          bf16x8 a = *(const bf16x8*)(ucb + (32 * T + r) * 72 + 16 * s + 8 * hh);
          ar[T] = mfma32(a, br, ar[T]);
          ai[T] = mfma32(a, bi, ai[T]);
        }
      }
    }
    {
      const float sp = fmaxf(xl, 0.f) + log1pf(expf(-fabsf(xl)));
  #pragma unroll
      for (int T = 0; T < 2; ++T)
  #pragma unroll
        for (int half = 0; half < 2; ++half) {
          float lv[8], bv[8];
  #pragma unroll
          for (int e = 0; e < 8; ++e) {
            const int reg = 8 * half + e;
            const int t = 32 * T + (reg & 3) + 8 * (reg >> 2) + 4 * hh;
            const float ucv = ucf[t * 64 + jj];
            const float rg = sigm(ar[T][reg] + brr);
            const float ig = sigm(ai[T][reg] + bii);
            const float la2 = (-8.f * 1.4426950408889634f) * rg * sp;
            const float a = __builtin_amdgcn_exp2f(la2);
            lv[e] = la2;
            bv[e] = __builtin_amdgcn_sqrtf(fmaxf(1.f - a * a, 0.f)) * (ig * ucv);
          }
          uint4 pl, pbv;
          pl.x = pack2(lv[0], lv[1]); pl.y = pack2(lv[2], lv[3]); pl.z = pack2(lv[4], lv[5]); pl.w = pack2(lv[6], lv[7]);
          pbv.x = pack2(bv[0], bv[1]); pbv.y = pack2(bv[2], bv[3]); pbv.z = pack2(bv[4], bv[5]); pbv.w = pack2(bv[6], bv[7]);
          {
            bf16_t* lp = labp + 32 * T + 16 * half + 4 * hh;
            *(uint2*)(lp) = uint2{pl.x, pl.y};
            *(uint2*)(lp + 8) = uint2{pl.z, pl.w};
            *(uint2*)(lp + 4096) = uint2{pbv.x, pbv.y};
            *(uint2*)(lp + 4096 + 8) = uint2{pbv.z, pbv.w};
          }
          ar[T][8 * half + 0] = __builtin_amdgcn_exp2f(bflo(pl.x)); ar[T][8 * half + 1] = __builtin_amdgcn_exp2f(bfhi(pl.x));
          ar[T][8 * half + 2] = __builtin_amdgcn_exp2f(bflo(pl.y)); ar[T][8 * half + 3] = __builtin_amdgcn_exp2f(bfhi(pl.y));
          ar[T][8 * half + 4] = __builtin_amdgcn_exp2f(bflo(pl.z)); ar[T][8 * half + 5] = __builtin_amdgcn_exp2f(bfhi(pl.z));
          ar[T][8 * half + 6] = __builtin_amdgcn_exp2f(bflo(pl.w)); ar[T][8 * half + 7] = __builtin_amdgcn_exp2f(bfhi(pl.w));
          ai[T][8 * half + 0] = bflo(pbv.x); ai[T][8 * half + 1] = bfhi(pbv.x); ai[T][8 * half + 2] = bflo(pbv.y); ai[T][8 * half + 3] = bfhi(pbv.y);
          ai[T][8 * half + 4] = bflo(pbv.z); ai[T][8 * half + 5] = bfhi(pbv.z); ai[T][8 * half + 6] = bflo(pbv.w); ai[T][8 * half + 7] = bfhi(pbv.w);
        }
    }
  }
  float cA[8], cB[8];
#pragma unroll
  for (int k = 0; k < 8; ++k) {
    const int T = k >> 2, g = k & 3;
    float A = 1.f, B = 0.f;
    if (dir == 0) {
#pragma unroll
      for (int e = 0; e < 4; ++e) { float a = ar[T][4 * g + e]; B = a * B + ai[T][4 * g + e]; A *= a; }
    } else {
#pragma unroll
      for (int e = 3; e >= 0; --e) { float a = ar[T][4 * g + e]; B = a * B + ai[T][4 * g + e]; A *= a; }
    }
    cA[k] = A; cB[k] = B;
  }
  float loA[8], loB[8], hiA[8], hiB[8];
#pragma unroll
  for (int k = 0; k < 8; ++k) {
    float pA = __shfl_xor(cA[k], 32), pB = __shfl_xor(cB[k], 32);
    loA[k] = hh ? pA : cA[k]; loB[k] = hh ? pB : cB[k];
    hiA[k] = hh ? cA[k] : pA; hiB[k] = hh ? cB[k] : pB;
  }
  if (pass == 1) {
    float A = 1.f, B = 0.f;
    if (dir == 0) {
#pragma unroll
      for (int k = 0; k < 8; ++k) { B = loA[k] * B + loB[k]; A *= loA[k]; B = hiA[k] * B + hiB[k]; A *= hiA[k]; }
    } else {
#pragma unroll
      for (int k = 7; k >= 0; --k) { B = hiA[k] * B + hiB[k]; A *= hiA[k]; B = loA[k] * B + loB[k]; A *= loA[k]; }
    }
    if (hh == 0) {
      float2* ag = (float2*)p.agg + ((size_t)(b * 2 + dir) * NCHUNK + chunk) * 1024 + gch;
      *ag = float2{A, B};
    }
    __syncthreads();
    return;
  }
  float st[8];
  {
    float h = hin;
    if (dir == 0) {
#pragma unroll
      for (int k = 0; k < 8; ++k) {
        float s_lo = h; h = loA[k] * h + loB[k];
        float s_hi = h; h = hiA[k] * h + hiB[k];
        st[k] = hh ? s_hi : s_lo;
      }
    } else {
#pragma unroll
      for (int k = 7; k >= 0; --k) {
        float s_hi = h; h = hiA[k] * h + hiB[k];
        float s_lo = h; h = loA[k] * h + loB[k];
        st[k] = hh ? s_hi : s_lo;
      }
    }
  }
#pragma unroll
  for (int k = 0; k < 8; ++k) {
    const int T = k >> 2, g = k & 3;
    float h = st[k];
    if (dir == 0) {
#pragma unroll
      for (int e = 0; e < 4; ++e) { h = ar[T][4 * g + e] * h + ai[T][4 * g + e]; ar[T][4 * g + e] = h; }
    } else {
#pragma unroll
      for (int e = 3; e >= 0; --e) { h = ar[T][4 * g + e] * h + ai[T][4 * g + e]; ar[T][4 * g + e] = h; }
    }
  }
  if (dir == 0) {
#pragma unroll
    for (int T = 0; T < 2; ++T)
#pragma unroll
      for (int reg = 0; reg < 16; ++reg) {
        const int t = 32 * T + (reg & 3) + 8 * (reg >> 2) + 4 * hh;
        ybuf[t * 64 + jj] = ar[T][reg];
      }
  }
  __syncthreads();
  if (dir == 1) {
#pragma unroll
    for (int T = 0; T < 2; ++T)
#pragma unroll
      for (int reg = 0; reg < 16; ++reg) {
        const int t = 32 * T + (reg & 3) + 8 * (reg >> 2) + 4 * hh;
        ybuf[t * 64 + jj] += ar[T][reg];
      }
  }
  __syncthreads();
  {
    const int tok = tid >> 2, cg4 = tid & 3;
    bf16_t* gp = p.P + (rowbase + t0 + tok) * DIN + C_GB + blk * 64 + cg4 * 16;
    const float* yp = ybuf + tok * 64 + cg4 * 16;
#pragma unroll
    for (int hq = 0; hq < 2; ++hq) {
      uint4 g = *(const uint4*)(gp + 8 * hq);
      uint4 o;
      o.x = pack2(yp[8 * hq + 0] * silu(bflo(g.x)), yp[8 * hq + 1] * silu(bfhi(g.x)));
      o.y = pack2(yp[8 * hq + 2] * silu(bflo(g.y)), yp[8 * hq + 3] * silu(bfhi(g.y)));
      o.z = pack2(yp[8 * hq + 4] * silu(bflo(g.z)), yp[8 * hq + 5] * silu(bfhi(g.z)));
      o.w = pack2(yp[8 * hq + 6] * silu(bflo(g.w)), yp[8 * hq + 7] * silu(bfhi(g.w)));
      if (!dry) *(uint4*)(gp + 8 * hq) = o;
    }
  }
  __syncthreads();
}

DI void lru1_run(const Params& p, int l, int j0, int nb, int n_l, char* smem) {
  if (j0 >= n_l) return;
  float* ucf = (float*)smem;
  bf16_t* ucb = (bf16_t*)(smem + 16384);
  bf16_t* us = (bf16_t*)(smem + 25600);
  typedef unsigned u32x4 __attribute__((ext_vector_type(4)));
  const int tid = opaque_tid(), w = tid >> 6, lane = tid & 63, r = lane & 31, hh = lane >> 5;
  const int dir = w >> 1, chh = w & 1;
  const int jj = 32 * chh + r;
  const int blk = j0 & 15;
  const int gch = blk * 64 + jj;
  bf16x8 wbr[4], wbi[4];
  {
    const bf16_t* gw = p.Wg + (size_t)((dir * 2 + 0) * 16 + blk) * 4096 + jj * 64 + 8 * hh;
#pragma unroll
    for (int s = 0; s < 4; ++s) { wbr[s] = *(const bf16x8*)(gw + 16 * s); wbi[s] = *(const bf16x8*)(gw + 16 * 4096 + 16 * s); }
  }
  const float brr = p.gate_b[((l * 2 + dir) * 2 + 0) * 1024 + gch];
  const float bii = p.gate_b[((l * 2 + dir) * 2 + 1) * 1024 + gch];
  const float xl = -p.lam[(l * 2 + dir) * 1024 + gch];
  const float sp = fmaxf(xl, 0.f) + log1pf(expf(-fabsf(xl)));
  const int cch = tid & 63, tg = tid >> 6;
  const float* cw = p.conv_w + (size_t)l * 4 * 1024 + blk * 64 + cch;
  const float w0 = cw[0], w1 = cw[1024], w2 = cw[2048], w3 = cw[3072];
  const float cb = p.conv_b[l * 1024 + blk * 64 + cch];
  u32x4 pu0, pu1, pu2;
#define LRU_LOADU(J) { \
    const int rest_ = (J) >> 4; const int chunk_ = rest_ % NCHUNK, b_ = rest_ / NCHUNK; const int t0_ = chunk_ * 64; \
    const int lo_ = (t0_ < CTXL) ? 0 : CTXL, hi_ = (t0_ < CTXL) ? CTXL : TOK; \
    const bf16_t* ub_ = p.P + ((size_t)b_ * TOK) * DIN + C_U + blk * 64; \
    { const int c_ = tid; const int t_ = t0_ - 2 + (c_ >> 3); pu0 = u32x4{0u, 0u, 0u, 0u}; if (t_ >= lo_ && t_ < hi_) pu0 = *(const u32x4*)(ub_ + (size_t)t_ * DIN + (c_ & 7) * 8); } \
    { const int c_ = tid + 256; const int t_ = t0_ - 2 + (c_ >> 3); pu1 = u32x4{0u, 0u, 0u, 0u}; if (t_ >= lo_ && t_ < hi_) pu1 = *(const u32x4*)(ub_ + (size_t)t_ * DIN + (c_ & 7) * 8); } \
    { const int c_ = tid + 512; const int t_ = t0_ - 2 + (c_ >> 3); pu2 = u32x4{0u, 0u, 0u, 0u}; if (c_ < 536 && t_ >= lo_ && t_ < hi_) pu2 = *(const u32x4*)(ub_ + (size_t)t_ * DIN + (c_ & 7) * 8); } }
  LRU_LOADU(j0)
  for (int j = j0; j < n_l; j += nb) {
    const int rest = j >> 4;
    const int chunk = rest % NCHUNK, b = rest / NCHUNK;
    const int item_index = (b * NCHUNK + chunk) * 16 + blk;
    *(u32x4*)(us + (tid >> 3) * 64 + (tid & 7) * 8) = pu0;
    *(u32x4*)(us + ((tid + 256) >> 3) * 64 + (tid & 7) * 8) = pu1;
    if (tid + 512 < 536) *(u32x4*)(us + ((tid + 512) >> 3) * 64 + (tid & 7) * 8) = pu2;
    __syncthreads();
    if (j + nb < n_l) LRU_LOADU(j + nb)
    {
      float x0 = bf2f(us[(16 * tg + 0) * 64 + cch]), x1 = bf2f(us[(16 * tg + 1) * 64 + cch]), x2 = bf2f(us[(16 * tg + 2) * 64 + cch]);
#pragma unroll
      for (int i = 0; i < 16; ++i) {
        float x3 = bf2f(us[(16 * tg + i + 3) * 64 + cch]);
        float o = x0 * w0;
        o += x1 * w1; o += x2 * w2; o += x3 * w3; o += cb;
        const int tok = 16 * tg + i;
        ucf[tok * 64 + cch] = o;
        ucb[tok * 72 + cch] = (bf16_t)f2bf(o);
        x0 = x1; x1 = x2; x2 = x3;
      }
    }
    __syncthreads();
    f32x16 ar[2], ai[2];
#pragma unroll
    for (int T = 0; T < 2; ++T)
#pragma unroll
      for (int i = 0; i < 16; ++i) { ar[T][i] = 0.f; ai[T][i] = 0.f; }
#pragma unroll
    for (int s = 0; s < 4; ++s)
#pragma unroll
      for (int T = 0; T < 2; ++T) {
        bf16x8 a = *(const bf16x8*)(ucb + (32 * T + r) * 72 + 16 * s + 8 * hh);
        ar[T] = mfma32(a, wbr[s], ar[T]);
        ai[T] = mfma32(a, wbi[s], ai[T]);
      }
    bf16_t* labp = p.lab + (size_t)item_index * 16384 + dir * 8192 + jj * 64;
#pragma unroll
    for (int T = 0; T < 2; ++T)
#pragma unroll
      for (int half = 0; half < 2; ++half) {
        float lv[8], bv[8];
#pragma unroll
        for (int e = 0; e < 8; ++e) {
          const int reg = 8 * half + e;
          const int t = 32 * T + (reg & 3) + 8 * (reg >> 2) + 4 * hh;
          const float ucv = ucf[t * 64 + jj];
          const float rg = sigm(ar[T][reg] + brr);
          const float ig = sigm(ai[T][reg] + bii);
          const float la2 = (-8.f * 1.4426950408889634f) * rg * sp;
          const float a = __builtin_amdgcn_exp2f(la2);
          lv[e] = la2;
          bv[e] = __builtin_amdgcn_sqrtf(fmaxf(1.f - a * a, 0.f)) * (ig * ucv);
        }
        uint4 pl, pbv;
        pl.x = pack2(lv[0], lv[1]); pl.y = pack2(lv[2], lv[3]); pl.z = pack2(lv[4], lv[5]); pl.w = pack2(lv[6], lv[7]);
        pbv.x = pack2(bv[0], bv[1]); pbv.y = pack2(bv[2], bv[3]); pbv.z = pack2(bv[4], bv[5]); pbv.w = pack2(bv[6], bv[7]);
        {
          bf16_t* lp = labp + 32 * T + 16 * half + 4 * hh;
          *(uint2*)(lp) = uint2{pl.x, pl.y};
          *(uint2*)(lp + 8) = uint2{pl.z, pl.w};
          *(uint2*)(lp + 4096) = uint2{pbv.x, pbv.y};
          *(uint2*)(lp + 4096 + 8) = uint2{pbv.z, pbv.w};
        }
        ar[T][8 * half + 0] = __builtin_amdgcn_exp2f(bflo(pl.x)); ar[T][8 * half + 1] = __builtin_amdgcn_exp2f(bfhi(pl.x));
        ar[T][8 * half + 2] = __builtin_amdgcn_exp2f(bflo(pl.y)); ar[T][8 * half + 3] = __builtin_amdgcn_exp2f(bfhi(pl.y));
        ar[T][8 * half + 4] = __builtin_amdgcn_exp2f(bflo(pl.z)); ar[T][8 * half + 5] = __builtin_amdgcn_exp2f(bfhi(pl.z));
        ar[T][8 * half + 6] = __builtin_amdgcn_exp2f(bflo(pl.w)); ar[T][8 * half + 7] = __builtin_amdgcn_exp2f(bfhi(pl.w));
        ai[T][8 * half + 0] = bflo(pbv.x); ai[T][8 * half + 1] = bfhi(pbv.x); ai[T][8 * half + 2] = bflo(pbv.y); ai[T][8 * half + 3] = bfhi(pbv.y);
        ai[T][8 * half + 4] = bflo(pbv.z); ai[T][8 * half + 5] = bfhi(pbv.z); ai[T][8 * half + 6] = bflo(pbv.w); ai[T][8 * half + 7] = bfhi(pbv.w);
      }
    float cA[8], cB[8];
#pragma unroll
    for (int k = 0; k < 8; ++k) {
      const int T = k >> 2, g = k & 3;
      float A = 1.f, B = 0.f;
      if (dir == 0) {
#pragma unroll
        for (int e = 0; e < 4; ++e) { float a = ar[T][4 * g + e]; B = a * B + ai[T][4 * g + e]; A *= a; }
      } else {
#pragma unroll
        for (int e = 3; e >= 0; --e) { float a = ar[T][4 * g + e]; B = a * B + ai[T][4 * g + e]; A *= a; }
      }
      cA[k] = A; cB[k] = B;
    }
    float A = 1.f, B = 0.f;
    if (dir == 0) {
#pragma unroll
      for (int k = 0; k < 8; ++k) {
        const float pA = __shfl_xor(cA[k], 32), pB = __shfl_xor(cB[k], 32);
        const float loA = hh ? pA : cA[k], loB = hh ? pB : cB[k], hiA = hh ? cA[k] : pA, hiB = hh ? cB[k] : pB;
        B = loA * B + loB; A *= loA; B = hiA * B + hiB; A *= hiA;
      }
    } else {
#pragma unroll
      for (int k = 7; k >= 0; --k) {
        const float pA = __shfl_xor(cA[k], 32), pB = __shfl_xor(cB[k], 32);
        const float loA = hh ? pA : cA[k], loB = hh ? pB : cB[k], hiA = hh ? cA[k] : pA, hiB = hh ? cB[k] : pB;
        B = hiA * B + hiB; A *= hiA; B = loA * B + loB; A *= loA;
      }
    }
    if (hh == 0) {
      float2* ag = (float2*)p.agg + ((size_t)(b * 2 + dir) * NCHUNK + chunk) * 1024 + gch;
      *ag = float2{A, B};
    }
    __syncthreads();
  }
#undef LRU_LOADU
}

DI void lru2_wave(const Params& p, int wi, bool last, bool dry) {
  const int lane = opaque_tid() & 63;
  const int blk = wi & 15, rest = wi >> 4;
  const int chunk = rest % NCHUNK, b = rest / NCHUNK;
  if (last && chunk < 4) return;
  const int gch = blk * 64 + lane;
  const float2* ag0 = (const float2*)p.agg + ((size_t)(b * 2 + 0) * NCHUNK) * 1024 + gch;
  const float2* ag1 = (const float2*)p.agg + ((size_t)(b * 2 + 1) * NCHUNK) * 1024 + gch;
  float hf = fold_range(ag0, 0, chunk, 1, 0.f);
  float hr = 0.f;
  if (chunk < 4) {
    hr = fold_range(ag1, 3, 3 - chunk, -1, hr);
  } else {
    hr = fold_range(ag1, 3, 4, -1, hr);
    hr = fold_range(ag1, NCHUNK - 1, NCHUNK - 1 - chunk, -1, hr);
  }
  const bf16_t* lp = p.lab + (size_t)wi * 16384 + lane * 64;
  float y[64];
  {
    uint4 la[8], bb[8];
#pragma unroll
    for (int q = 0; q < 8; ++q) { la[q] = *(const uint4*)(lp + q * 8); bb[q] = *(const uint4*)(lp + 4096 + q * 8); }
    float h = hf;
#pragma unroll
    for (int q = 0; q < 8; ++q) {
      h = __builtin_amdgcn_exp2f(bflo(la[q].x)) * h + bflo(bb[q].x); y[8 * q + 0] = h;
      h = __builtin_amdgcn_exp2f(bfhi(la[q].x)) * h + bfhi(bb[q].x); y[8 * q + 1] = h;
      h = __builtin_amdgcn_exp2f(bflo(la[q].y)) * h + bflo(bb[q].y); y[8 * q + 2] = h;
      h = __builtin_amdgcn_exp2f(bfhi(la[q].y)) * h + bfhi(bb[q].y); y[8 * q + 3] = h;
      h = __builtin_amdgcn_exp2f(bflo(la[q].z)) * h + bflo(bb[q].z); y[8 * q + 4] = h;
      h = __builtin_amdgcn_exp2f(bfhi(la[q].z)) * h + bfhi(bb[q].z); y[8 * q + 5] = h;
      h = __builtin_amdgcn_exp2f(bflo(la[q].w)) * h + bflo(bb[q].w); y[8 * q + 6] = h;
      h = __builtin_amdgcn_exp2f(bfhi(la[q].w)) * h + bfhi(bb[q].w); y[8 * q + 7] = h;
    }
  }
  {
    uint4 la[8], bb[8];
#pragma unroll
    for (int q = 0; q < 8; ++q) { la[q] = *(const uint4*)(lp + 8192 + q * 8); bb[q] = *(const uint4*)(lp + 8192 + 4096 + q * 8); }
    float h = hr;
#pragma unroll
    for (int q = 7; q >= 0; --q) {
      h = __builtin_amdgcn_exp2f(bfhi(la[q].w)) * h + bfhi(bb[q].w); y[8 * q + 7] += h;
      h = __builtin_amdgcn_exp2f(bflo(la[q].w)) * h + bflo(bb[q].w); y[8 * q + 6] += h;
      h = __builtin_amdgcn_exp2f(bfhi(la[q].z)) * h + bfhi(bb[q].z); y[8 * q + 5] += h;
      h = __builtin_amdgcn_exp2f(bflo(la[q].z)) * h + bflo(bb[q].z); y[8 * q + 4] += h;
      h = __builtin_amdgcn_exp2f(bfhi(la[q].y)) * h + bfhi(bb[q].y); y[8 * q + 3] += h;
      h = __builtin_amdgcn_exp2f(bflo(la[q].y)) * h + bflo(bb[q].y); y[8 * q + 2] += h;
      h = __builtin_amdgcn_exp2f(bfhi(la[q].x)) * h + bfhi(bb[q].x); y[8 * q + 1] += h;
      h = __builtin_amdgcn_exp2f(bflo(la[q].x)) * h + bflo(bb[q].x); y[8 * q + 0] += h;
    }
  }
  bf16_t* gp = p.P + ((size_t)b * TOK + (size_t)chunk * 64) * DIN + C_GB + blk * 64 + lane;
#pragma unroll
  for (int t0 = 0; t0 < 64; t0 += 16) {
    bf16_t g[16];
#pragma unroll
    for (int i = 0; i < 16; ++i) g[i] = gp[(size_t)(t0 + i) * DIN];
#pragma unroll
    for (int i = 0; i < 16; ++i) {
      const float o = y[t0 + i] * silu(bf2f(g[i]));
      if (!dry) gp[(size_t)(t0 + i) * DIN] = (bf16_t)f2bf(o);
    }
  }
}

template <bool FAST>
DI void attn_item_t(const Params& p, int b, int hq, int qt0, int nkeys, char* smem, bool dry, bool primed, bf16x8 (&qf)[4],
                    int nb_, int nhq, int nqt0) {
  typedef bf16_t (*kv_t)[64][72];
  kv_t Ks = (kv_t)smem;
  kv_t Vs = (kv_t)(smem + 2 * 64 * 72 * 2);
  const int tid = opaque_tid(), w = tid >> 6, lane = tid & 63, r = lane & 31, hh = lane >> 5;
  const int kvh = hq >> 2;
  const size_t rowbase = (size_t)b * TOK;
  const size_t mq = rowbase + qt0 + 32 * w + r;
  bf16_t* prow = p.P + mq * DIN;
  const int lr = tid >> 3, lc = tid & 7;
  const bf16_t* kptr = p.P + (rowbase + lr) * DIN + C_K + kvh * 64 + lc * 8;
  const bf16_t* vptr = p.P + (rowbase + kvh * 16 + (lr >> 2)) * DIN + C_V + (lr & 3) * 64 + lc * 8;
  const bool hasnext = nhq >= 0;
  const size_t nrowbase = (size_t)(hasnext ? nb_ : b) * TOK;
  const int nkvh = (hasnext ? nhq : hq) >> 2;
  const bf16_t* nkptr = p.P + (nrowbase + lr) * DIN + C_K + nkvh * 64 + lc * 8;
  const bf16_t* nvptr = p.P + (nrowbase + nkvh * 16 + (lr >> 2)) * DIN + C_V + (lr & 3) * 64 + lc * 8;
  const bf16_t* nqptr = p.P + (nrowbase + (hasnext ? nqt0 : qt0) + 32 * w + r) * DIN + C_Q + (hasnext ? nhq : hq) * 64 + 8 * hh;
  bf16x8 qfn[4];
#pragma unroll
  for (int s = 0; s < 4; ++s) qfn[s] = qf[s];
  uint4 rk0, rk1, rv0, rv1;
  if (!primed) {
#pragma unroll
    for (int s = 0; s < 4; ++s) qf[s] = *(const bf16x8*)(prow + C_Q + hq * 64 + 16 * s + 8 * hh);
    rk0 = *(const uint4*)(kptr); rk1 = *(const uint4*)(kptr + (size_t)32 * DIN);
    rv0 = *(const uint4*)(vptr); rv1 = *(const uint4*)(vptr + (size_t)8 * DIN);
    *(uint4*)&Ks[0][lr][lc * 8] = rk0; *(uint4*)&Ks[0][lr + 32][lc * 8] = rk1;
    *(uint4*)&Vs[0][lr][lc * 8] = rv0; *(uint4*)&Vs[0][lr + 32][lc * 8] = rv1;
    __syncthreads();
  }
  f32x16 negm;
#pragma unroll
  for (int i = 0; i < 16; ++i) negm[i] = 0.f;
  if (!FAST) {
    f32x16 s0, s1;
#pragma unroll
    for (int i = 0; i < 16; ++i) { s0[i] = 0.f; s1[i] = 0.f; }
#pragma unroll
    for (int s = 0; s < 4; ++s) {
      bf16x8 a0 = *(const bf16x8*)&Ks[0][r][16 * s + 8 * hh];
      bf16x8 a1 = *(const bf16x8*)&Ks[0][32 + r][16 * s + 8 * hh];
      s0 = mfma32(a0, qf[s], s0);
      s1 = mfma32(a1, qf[s], s1);
    }
    float mx = fmaxf(s0[0], s1[0]);
#pragma unroll
    for (int i = 1; i < 16; ++i) mx = fmaxf(fmaxf(mx, s0[i]), s1[i]);
    mx = fmaxf(mx, __shfl_xor(mx, 32));
#pragma unroll
    for (int i = 0; i < 16; ++i) negm[i] = -mx;
  }
  float lrun = 0.f;
  f32x16 o0, o1;
#pragma unroll
  for (int i = 0; i < 16; ++i) { o0[i] = 0.f; o1[i] = 0.f; }
  const int ntile = nkeys >> 6;
  for (int t = 0; t < ntile; ++t) {
    const int cur = t & 1;
    if (t + 1 < ntile) {
      const size_t ko = (size_t)(t + 1) * 64 * DIN;
      rk0 = *(const uint4*)(kptr + ko); rk1 = *(const uint4*)(kptr + ko + (size_t)32 * DIN);
      rv0 = *(const uint4*)(vptr + ko); rv1 = *(const uint4*)(vptr + ko + (size_t)8 * DIN);
    } else if (hasnext) {
      rk0 = *(const uint4*)(nkptr); rk1 = *(const uint4*)(nkptr + (size_t)32 * DIN);
      rv0 = *(const uint4*)(nvptr); rv1 = *(const uint4*)(nvptr + (size_t)8 * DIN);
#pragma unroll
      for (int s = 0; s < 4; ++s) qfn[s] = *(const bf16x8*)(nqptr + 16 * s);
    }
    f32x16 s0, s1;
    __builtin_amdgcn_s_setprio(1);
    {
      bf16x8 a0 = *(const bf16x8*)&Ks[cur][r][8 * hh];
      bf16x8 a1 = *(const bf16x8*)&Ks[cur][32 + r][8 * hh];
      if (FAST) {
        f32x16 z;
#pragma unroll
        for (int i = 0; i < 16; ++i) z[i] = 0.f;
        s0 = mfma32(a0, qf[0], z);
        s1 = mfma32(a1, qf[0], z);
      } else {
        s0 = mfma32(a0, qf[0], negm);
        s1 = mfma32(a1, qf[0], negm);
      }
    }
#pragma unroll
    for (int s = 1; s < 4; ++s) {
      bf16x8 a0 = *(const bf16x8*)&Ks[cur][r][16 * s + 8 * hh];
      bf16x8 a1 = *(const bf16x8*)&Ks[cur][32 + r][16 * s + 8 * hh];
      s0 = mfma32(a0, qf[s], s0);
      s1 = mfma32(a1, qf[s], s1);
    }
    __builtin_amdgcn_s_setprio(0);
    float mx = 0.f;
    if (!FAST) {
      mx = fmaxf(s0[0], s1[0]);
#pragma unroll
      for (int i = 1; i < 16; ++i) mx = fmaxf(fmaxf(mx, s0[i]), s1[i]);
    }
    float rs0 = 0.f, rs1 = 0.f;
#pragma unroll
    for (int i = 0; i < 16; ++i) { s0[i] = __builtin_amdgcn_exp2f(s0[i]); rs0 += s0[i]; }
#pragma unroll
    for (int i = 0; i < 16; ++i) { s1[i] = __builtin_amdgcn_exp2f(s1[i]); rs1 += s1[i]; }
    lrun += rs0 + rs1;
    bf16x8 pb[2][2];
#pragma unroll
    for (int s = 0; s < 2; ++s) {
      unsigned u0 = pack2(s0[8 * s + 0], s0[8 * s + 1]), u1 = pack2(s0[8 * s + 2], s0[8 * s + 3]);
      unsigned u2 = pack2(s0[8 * s + 4], s0[8 * s + 5]), u3 = pack2(s0[8 * s + 6], s0[8 * s + 7]);
      uint4 uu = uint4{u0, u1, u2, u3};
      pb[0][s] = __builtin_bit_cast(bf16x8, uu);
      unsigned w0 = pack2(s1[8 * s + 0], s1[8 * s + 1]), w1 = pack2(s1[8 * s + 2], s1[8 * s + 3]);
      unsigned w2 = pack2(s1[8 * s + 4], s1[8 * s + 5]), w3 = pack2(s1[8 * s + 6], s1[8 * s + 7]);
      uint4 ww = uint4{w0, w1, w2, w3};
      pb[1][s] = __builtin_bit_cast(bf16x8, ww);
    }
#pragma unroll
    for (int kh = 0; kh < 2; ++kh)
#pragma unroll
      for (int s = 0; s < 2; ++s) {
        const int kc = 32 * kh + 16 * s + 8 * hh;
        bf16x8 va0 = *(const bf16x8*)&Vs[cur][r][kc];
        bf16x8 va1 = *(const bf16x8*)&Vs[cur][32 + r][kc];
        o0 = mfma32(va0, pb[kh][s], o0);
        o1 = mfma32(va1, pb[kh][s], o1);
      }
    if (!FAST && __builtin_amdgcn_ballot_w64(mx > 12.f) != 0ull) {
      const float mxp = fmaxf(mx, __shfl_xor(mx, 32));
      const float shift = mxp > 12.f ? mxp : 0.f;
      const float f = __builtin_amdgcn_exp2f(-shift);
      lrun *= f;
#pragma unroll
      for (int i = 0; i < 16; ++i) { o0[i] *= f; o1[i] *= f; negm[i] -= shift; }
    }
    if (t + 1 < ntile || hasnext) {
      *(uint4*)&Ks[cur ^ 1][lr][lc * 8] = rk0; *(uint4*)&Ks[cur ^ 1][lr + 32][lc * 8] = rk1;
      *(uint4*)&Vs[cur ^ 1][lr][lc * 8] = rv0; *(uint4*)&Vs[cur ^ 1][lr + 32][lc * 8] = rv1;
    }
    __syncthreads();
  }
  const float ltot = lrun + __shfl_xor(lrun, 32);
  const float inv = 1.f / ltot;
#pragma unroll
  for (int dh = 0; dh < 2; ++dh)
#pragma unroll
    for (int g = 0; g < 4; ++g) {
      const int d0 = 32 * dh + 8 * g + 4 * hh;
      uint2 gau = *(const uint2*)(prow + C_GA + hq * 64 + d0);
      float v0 = (dh ? o1[4 * g + 0] : o0[4 * g + 0]) * inv * silu(bflo(gau.x));
      float v1 = (dh ? o1[4 * g + 1] : o0[4 * g + 1]) * inv * silu(bfhi(gau.x));
      float v2 = (dh ? o1[4 * g + 2] : o0[4 * g + 2]) * inv * silu(bflo(gau.y));
      float v3 = (dh ? o1[4 * g + 3] : o0[4 * g + 3]) * inv * silu(bfhi(gau.y));
      uint2 o; o.x = pack2(v0, v1); o.y = pack2(v2, v3);
      if (!dry) *(uint2*)(prow + C_Q + hq * 64 + d0) = o;
    }
#pragma unroll
  for (int s = 0; s < 4; ++s) qf[s] = qfn[s];
}

DI void attn_item(const Params& p, int l, int b, int hq, int qt0, int nkeys, char* smem, bool dry, bool primed, bf16x8 (&qf)[4],
                  int nb_, int nhq, int nqt0) {
  const int lane = opaque_tid() & 63;
  float gq = fabsf(p.q_norm_g[l * 64 + lane]), gk = fabsf(p.k_norm_g[l * 64 + lane]);
#pragma unroll
  for (int off = 32; off >= 1; off >>= 1) { gq = fmaxf(gq, __shfl_xor(gq, off)); gk = fmaxf(gk, __shfl_xor(gk, off)); }
  const float bound = 64.f * 0.125f * 1.4426950408889634f * gq * gk * 1.01f;
  if (__builtin_amdgcn_readfirstlane(bound < 60.f ? 1 : 0)) attn_item_t<true>(p, b, hq, qt0, nkeys, smem, dry, primed, qf, nb_, nhq, nqt0);
  else attn_item_t<false>(p, b, hq, qt0, nkeys, smem, dry, primed, qf, nb_, nhq, nqt0);
}

#define XB_TMO      128
#define XB_XCNT(j)  (256  + 64 * (j))
#define XB_XSUB(j)  (1280 + 64 * (j))
#define XB_XGEN(j)  (2304 + 64 * (j))
#define XB_TOP      3328
#define XB_TOPGEN   3392
#define XCD_BAR_WORDS 3456
#define XB_SPIN_CAP (1u << 20)
#define LAS __attribute__((address_space(3)))
DI unsigned xb_ld(unsigned* p) { return __hip_atomic_load(p, __ATOMIC_RELAXED, __HIP_MEMORY_SCOPE_AGENT); }
DI unsigned xb_add(unsigned* p, unsigned v) { return __hip_atomic_fetch_add(p, v, __ATOMIC_RELAXED, __HIP_MEMORY_SCOPE_AGENT); }
DI unsigned xb_xcc_id() { return (unsigned)__builtin_amdgcn_s_getreg((3 << 11) | 20) & 0xFu; }
#define XB_SPIN(cond, bar) do { unsigned _sp = 0; while (cond) { __builtin_amdgcn_s_sleep(1); \
    if ((++_sp & 255u) == 0u) { if (xb_ld(&(bar)[XB_TMO])) break; if (_sp > XB_SPIN_CAP) { atomicAdd(&(bar)[XB_TMO], 1u); break; } } } } while (0)
struct XcdBarrier { unsigned* bar; unsigned x; volatile LAS unsigned* st; };
DI XcdBarrier xcd_barrier_post(unsigned* bar, volatile LAS unsigned* st) {
  XcdBarrier b; b.bar = bar; b.x = xb_xcc_id(); b.st = st;
  if (threadIdx.x == 0) (void)xb_add(&bar[XB_XCNT(b.x)], 1u);
  return b;
}
DI void xcd_barrier_complete(unsigned* bar, unsigned x, unsigned& nloc, unsigned& nx) {
  const unsigned G = gridDim.x * gridDim.y * gridDim.z;
  unsigned sum, cnt, mine, sp = 0u;
  for (;;) {
    sum = 0u; cnt = 0u; mine = 0u;
#pragma unroll
    for (unsigned j = 0; j < 16; ++j) { const unsigned c = xb_ld(&bar[XB_XCNT(j)]); sum += c; cnt += (c > 0u) ? 1u : 0u; mine = (j == x) ? c : mine; }
    if (sum == G) break;
    __builtin_amdgcn_s_sleep(1);
    if ((++sp & 255u) == 0u) { if (xb_ld(&bar[XB_TMO])) break; if (sp > XB_SPIN_CAP) { atomicAdd(&bar[XB_TMO], 1u); break; } }
  }
  nloc = mine > 0u ? mine : 1u; nx = cnt > 0u ? cnt : 1u;
}
DI void xcd_barrier(const XcdBarrier& b) {
  asm volatile("s_waitcnt vmcnt(0)" ::: "memory");
  __syncthreads();
  if (threadIdx.x == 0) {
    unsigned* bar = b.bar;
    __builtin_amdgcn_s_waitcnt(0);
    unsigned nloc = b.st[0], nx = b.st[1];
    if (nloc == 0u) { xcd_barrier_complete(bar, b.x, nloc, nx); b.st[0] = nloc; b.st[1] = nx; }
    const unsigned old = xb_add(&bar[XB_XSUB(b.x)], 1u);
    const unsigned gen = old / nloc;
    if (old + 1u == (gen + 1u) * nloc) {
      __builtin_amdgcn_fence(__ATOMIC_RELEASE, "agent");
      asm volatile("s_waitcnt vmcnt(0)" ::: "memory");
      const unsigned og = xb_add(&bar[XB_TOP], 1u);
      const unsigned tg = og / nx;
      if (og + 1u == (tg + 1u) * nx) xb_add(&bar[XB_TOPGEN], 1u);
      else XB_SPIN(xb_ld(&bar[XB_TOPGEN]) == tg, bar);
      __builtin_amdgcn_fence(__ATOMIC_ACQUIRE, "agent");
      xb_add(&bar[XB_XGEN(b.x)], 1u);
      asm volatile("s_waitcnt vmcnt(0)" ::: "memory");
    } else {
      XB_SPIN(xb_ld(&bar[XB_XGEN(b.x)]) == gen, bar);
      __builtin_amdgcn_fence(__ATOMIC_ACQUIRE, "agent");
      asm volatile("s_waitcnt vmcnt(0)" ::: "memory");
    }
  }
  __syncthreads();
}

DI void run_phase(const Params& p, int ph, char* smem, bool dry, int sel) {
  const int bid = blockIdx.x, nb = gridDim.x;
  if (ph == 0) {
    for (int it = bid; it < 769; it += nb) {
      if (it < 768) mod_partial_item(p, it, smem); else rope_item(p);
    }
    return;
  }
  if (ph == 1) {
    for (int it = bid; it < 240; it += nb) mod_reduce_item(p, it);
    return;
  }
  const int l = (ph - 2) / 6, k = (ph - 2) % 6;
  const bool last = (l == 3);
  if (k == 0) {
    const int n_tr = 16 * 104, n_g = 64;
    const int n_items = n_tr + n_g + MALL / 4;
    int it = bid;
    for (; it < n_tr + n_g; it += nb) {
      if (it < n_tr) {
        int rt = it & 15, ct = it >> 4;
        transpose_tile(p.w_in + (size_t)l * 1024 * DIN, 1024, DIN, p.Wt_in, HP, rt * 64, ct * 64, smem);
      } else {
        int mat = it - n_tr;
        transpose_tile(p.gate_w + (size_t)l * 262144 + (size_t)mat * 4096, 64, 64, p.Wg + (size_t)mat * 4096, 64, 0, 0, smem);
      }
    }
    norm_run(p, l, it - n_tr - n_g, nb, n_items - n_tr - n_g);
  } else if (k == 1) {
    if ((nb & 7) == 0) {
      const int xcd = bid & 7, rm = xcd >> 1, rn = xcd & 1;
      const int jstep = nb >> 3;
      int j = bid >> 3;
#define G1_ITEM(JJ, OUT) { int mi_, ni_; \
        if ((JJ) < 34 * 24) { const int ch_ = (JJ) / 272, rr_ = (JJ) % 272; mi_ = rr_ >> 3; ni_ = ch_ * 8 + (rr_ & 7); } \
        else { const int rr_ = (JJ) - 34 * 24; mi_ = rr_ >> 1; ni_ = 24 + (rr_ & 1); } \
        OUT = (34 * rm + mi_) * 52 + 26 * rn + ni_; }
      bool primed = false;
      for (; j < 34 * 26; j += jstep) {
        int item, nitem = -1;
        G1_ITEM(j, item)
        if (j + jstep < 34 * 26) G1_ITEM(j + jstep, nitem)
        g1_tile(p, item, smem, primed, nitem);
        primed = nitem >= 0;
      }
#undef G1_ITEM
    } else {
      for (int it = bid; it < 136 * 52; it += nb) g1_tile(p, it, smem);
    }
  } else if (k == 2) {
    const int n_v = MALL / 64, n_q = n_v + MALL / 32, n_l = NBATCH * NCHUNK * 16, n_t = 3 * 256;
    if ((nb & 15) == 0 && sel == 0) {
      int it = bid;
      for (; it < n_q; it += nb) {
        if (it < n_v) vt_item(p, it, smem, dry); else qk_item(p, l, it - n_v, dry);
      }
      lru1_run(p, l, it - n_q, nb, n_l, smem);
      while (it < n_q + n_l) it += nb;
      for (; it < n_q + n_l + n_t; it += nb) {
        int j = it - n_q - n_l;
        int which = j >> 8, tt = j & 255;
        const float* src = (which == 0 ? p.w_a : (which == 1 ? p.w_b : p.w_o)) + (size_t)l * 1024 * 1024;
        transpose_tile(src, 1024, 1024, p.Wt_abo + (size_t)which * 1024 * HP, HP, (tt & 15) * 64, (tt >> 4) * 64, smem);
      }
    } else {
    for (int it = bid; it < n_q + n_l + n_t; it += nb) {
      if (sel == 1 && !(it >= n_q && it < n_q + n_l)) continue;
      if (sel == 2 && (it >= n_q && it < n_q + n_l)) continue;
      if (it < n_v) {
        vt_item(p, it, smem, dry);
      } else if (it < n_q) {
        qk_item(p, l, it - n_v, dry);
      } else if (it < n_q + n_l) {
        int j = it - n_q;
        int blk = j & 15, rest = j >> 4;
        lru_item(p, l, rest / NCHUNK, rest % NCHUNK, blk, 1, smem, dry);
      } else {
        int j = it - n_q - n_l;
        int which = j >> 8, tt = j & 255;
        const float* src = (which == 0 ? p.w_a : (which == 1 ? p.w_b : p.w_o)) + (size_t)l * 1024 * 1024;
        transpose_tile(src, 1024, 1024, p.Wt_abo + (size_t)which * 1024 * HP, HP, (tt & 15) * 64, (tt >> 4) * 64, smem);
      }
    }
    }
  } else if (k == 3) {
    const int n_al = 2048, n_ac = last ? 0 : 128, n_l = NBATCH * NCHUNK * 16;
    const bool lru_first = bid >= (nb >> 1);
    for (int stage = 0; stage < 2; ++stage) {
      const bool do_lru = (stage == 0) == lru_first;
      if (do_lru) {
        if (sel == 2) continue;
        for (int j = bid; j < (n_l >> 2); j += nb) lru2_wave(p, j * 4 + (opaque_tid() >> 6), last, dry);
      } else {
        if (sel == 1) continue;
#define ATT_DECODE(IT, B_, HQ_, QT0_, NK_) { \
          if ((IT) < n_al) { const int x_ = (IT) & 7, j_ = (IT) >> 3; const int pair_ = 2 * x_ + (j_ >> 7), idx_ = j_ & 127; \
            B_ = pair_ >> 2; HQ_ = (pair_ & 3) * 4 + (idx_ & 3); QT0_ = CTXL + (idx_ >> 2) * 128; NK_ = TOK; } \
          else { const int j_ = (IT) - n_al; B_ = j_ >> 5; HQ_ = (j_ >> 1) & 15; QT0_ = (j_ & 1) * 128; NK_ = CTXL; } }
        bool primed = false;
        bf16x8 qf[4];
#pragma unroll
        for (int s = 0; s < 4; ++s) qf[s] = bf16x8{0, 0, 0, 0, 0, 0, 0, 0};
        for (int it = bid; it < n_al + n_ac; it += nb) {
          int b, hq, qt0, nk, b2 = 0, hq2 = -1, qt02 = 0, nk2 = 0;
          ATT_DECODE(it, b, hq, qt0, nk)
          if (it + nb < n_al + n_ac) ATT_DECODE(it + nb, b2, hq2, qt02, nk2)
          (void)nk2;
          attn_item(p, l, b, hq, qt0, nk, smem, dry, primed, qf, b2, hq2, qt02);
          primed = hq2 >= 0;
        }
#undef ATT_DECODE
      }
    }
  } else {
    const int n_mt = last ? 128 : 136;
    if ((nb & 7) == 0) {
      const int xcd = bid & 7, mpx = n_mt >> 3;
      const int jstep = nb >> 3;
      bool primed = false;
      for (int j = bid >> 3; j < mpx * 8; j += jstep) {
        const int mi = xcd * mpx + (j >> 3), nt = j & 7;
        const int mt = last ? ((mi >> 5) * 34 + 2 + (mi & 31)) : mi;
        int nmt = -1, nnt = 0;
        if (j + jstep < mpx * 8) {
          const int mi2 = xcd * mpx + ((j + jstep) >> 3);
          nnt = (j + jstep) & 7;
          nmt = last ? ((mi2 >> 5) * 34 + 2 + (mi2 & 31)) : mi2;
        }
        if (k == 4) g2_tile(p, mt, nt, smem, dry, primed, nmt, nnt); else g3_tile(p, l, mt, nt, smem, dry, primed, nmt, nnt);
        primed = nmt >= 0;
      }
    } else {
      for (int it = bid; it < n_mt * 8; it += nb) {
        int mi = it >> 3, nt = it & 7;
        int mt = last ? ((mi >> 5) * 34 + 2 + (mi & 31)) : mi;
        if (k == 4) g2_tile(p, mt, nt, smem, dry); else g3_tile(p, l, mt, nt, smem, dry);
      }
    }
  }
}

__global__ void __launch_bounds__(256, 2) mega(Params p, int ph_begin, int ph_end, int coop, int dupmask) {
  extern __shared__ __attribute__((aligned(16))) char smem[];
  __shared__ uint4 xb_words;
  XcdBarrier xb;
  xb.bar = p.bar; xb.x = 0u; xb.st = (volatile LAS unsigned*)&xb_words;
  if (coop) {
    if (threadIdx.x == 0) xb_words = make_uint4(0u, 0u, 0u, 0u);
    __syncthreads();
    xb = xcd_barrier_post(p.bar, (volatile LAS unsigned*)&xb_words);
  }
  for (int ph = ph_begin; ph < ph_end; ++ph) {
    if (DUPMASK != 0 && dupmask) {
      const int kk = ph >= 2 ? (ph - 2) % 6 : 7;
      if ((dupmask >> kk) & 1) { run_phase(p, ph, smem, (dupmask & 0x100) != 0, (dupmask >> 9) & 3); if (coop == 1) xcd_barrier(xb); }
    }
    run_phase(p, ph, smem, false, 0);
    if (ph + 1 < ph_end) {
      if (coop == 1) xcd_barrier(xb);
      else if (coop == 2) cg::this_grid().sync();
    }
  }
}

extern "C" void kernel_launch(void* const* d_in, const int* in_sizes, int n_in, void* d_out, int out_size, void* d_ws,
                              size_t ws_size, hipStream_t stream) {
  Params p{};
  p.x = (const float*)d_in[0]; p.c = (const float*)d_in[1]; p.ctx = (const float*)d_in[2]; p.c_ctx = (const float*)d_in[3];
  p.norm_g = (const float*)d_in[4]; p.w_mod = (const float*)d_in[5]; p.b_mod = (const float*)d_in[6]; p.w_in = (const float*)d_in[7];
  p.q_norm_g = (const float*)d_in[8]; p.k_norm_g = (const float*)d_in[9]; p.conv_w = (const float*)d_in[10];
  p.conv_b = (const float*)d_in[11]; p.gate_w = (const float*)d_in[12]; p.gate_b = (const float*)d_in[13];
  p.lam = (const float*)d_in[14]; p.w_a = (const float*)d_in[15]; p.w_b = (const float*)d_in[16]; p.w_o = (const float*)d_in[17];
  p.out = (float*)d_out;
  char* ws = (char*)d_ws;
  size_t off = 0;
  p.P = (bf16_t*)(ws + off); off += (size_t)MALL * DIN * 2;
  p.Hs = (bf16_t*)(ws + off); p.agg = (float*)(ws + off); off += (size_t)MALL * HP * 2;
  p.Wt_in = (bf16_t*)(ws + off); p.Wt_abo = (bf16_t*)(ws + off); off += (size_t)DIN * HP * 2;
  p.Xctx = (float*)(ws + off); off += (size_t)NBATCH * CTXL * DM * 4;
  p.mod = (float*)(ws + off); off += (size_t)4 * 5 * 3072 * 4;
  p.rope = (float*)(ws + off); off += (size_t)64 * 16 * 2 * 4;
  p.bar = (unsigned*)(ws + off); off += (size_t)XCD_BAR_WORDS * 4;
  p.Wg = (bf16_t*)(ws + off); off += (size_t)262144 * 2;
  p.modp = (float*)(ws + off); off += (size_t)16 * 61440 * 4;
  p.lab = (bf16_t*)(ws + off); off += (size_t)NBATCH * NCHUNK * 16 * 32768;
  if (off > ws_size) { fprintf(stderr, "workspace too small: need %zu have %zu\n", off, ws_size); return; }

  static int grid_blocks = 0;
  if (!grid_blocks) {
    int dev = 0, cus = 0, per_cu = 0;
    hipGetDevice(&dev);
    hipDeviceGetAttribute(&cus, hipDeviceAttributeMultiprocessorCount, dev);
    hipFuncSetAttribute((const void*)mega, hipFuncAttributeMaxDynamicSharedMemorySize, SMEM_BYTES);
    hipOccupancyMaxActiveBlocksPerMultiprocessor(&per_cu, mega, 256, SMEM_BYTES);
    if (per_cu < 1) per_cu = 1;
    if (per_cu > 2) per_cu = 2;
    grid_blocks = cus * per_cu;
  }
#if MULTI
  for (int ph = 0; ph < NPH; ++ph) {
    hipLaunchKernelGGL(mega, dim3(grid_blocks), dim3(256), SMEM_BYTES, stream, p, ph, ph + 1, 0, 0);
  }
#else
  hipMemsetAsync(p.bar, 0, (size_t)XCD_BAR_WORDS * 4, stream);
  int b0 = 0, e0 = NPH, coop = 1, dupmask = DUPMASK;
  void* args[] = {&p, &b0, &e0, &coop, &dupmask};
  hipError_t e = hipLaunchCooperativeKernel((const void*)mega, dim3(grid_blocks), dim3(256), args, SMEM_BYTES, stream);
  if (e != hipSuccess) fprintf(stderr, "cooperative launch failed: %s (grid %d)\n", hipGetErrorString(e), grid_blocks);
#endif
}
```

```cpp
#include <hip/hip_runtime.h>
#include <hip/hip_cooperative_groups.h>
#include <stdint.h>
#include <stdio.h>
namespace cg = cooperative_groups;

#ifndef MULTI
#define MULTI 0
#endif

#ifndef DUPMASK
#define DUPMASK 0
#endif
#define DI __device__ __forceinline__
typedef unsigned short bf16_t;
typedef __attribute__((ext_vector_type(8))) short bf16x8;
typedef __attribute__((ext_vector_type(4))) short s16x4;
typedef __attribute__((ext_vector_type(4))) float f32x4;
typedef __attribute__((ext_vector_type(16))) float f32x16;

constexpr int DM = 1024;
constexpr int NBATCH = 4;
constexpr int SEQ = 4096;
constexpr int CTXL = 256;
constexpr int TOK = SEQ + CTXL;
constexpr int MALL = NBATCH * TOK;
constexpr int MHALF = MALL / 2;
constexpr int DIN = 6656;
constexpr int HP = 1024;
constexpr int C_Q = 0, C_K = 1024, C_V = 1280, C_GA = 1536, C_U = 2560, C_GB = 3584, C_GM = 4608;
constexpr int NCHUNK = TOK / 64;
constexpr int SMEM_BYTES = 73728;
constexpr int NPH = 2 + 6 * 4;

struct Params {
  const float* x; const float* c; const float* ctx; const float* c_ctx; const float* norm_g; const float* w_mod;
  const float* b_mod; const float* w_in; const float* q_norm_g; const float* k_norm_g; const float* conv_w;
  const float* conv_b; const float* gate_w; const float* gate_b; const float* lam; const float* w_a; const float* w_b;
  const float* w_o;
  float* out;
  bf16_t* P;
  bf16_t* Hs;
  float* agg;
  bf16_t* Wt_in;
  bf16_t* Wt_abo;
  float* Xctx;
  float* mod;
  float* rope;
  bf16_t* Wg;
  float* modp;
  bf16_t* lab;
  unsigned* bar;
};

typedef float f32x2_t __attribute__((ext_vector_type(2)));
typedef __bf16 bf16x2_t __attribute__((ext_vector_type(2)));
DI unsigned pack2(float a, float b) { f32x2_t v = {a, b}; bf16x2_t r = __builtin_convertvector(v, bf16x2_t); return __builtin_bit_cast(unsigned, r); }
DI unsigned f2bf(float x) { return pack2(x, 0.f) & 0xffffu; }
DI float bflo(unsigned u) { return __uint_as_float(u << 16); }
DI float bfhi(unsigned u) { return __uint_as_float(u & 0xffff0000u); }
DI float bf2f(bf16_t b) { return __uint_as_float(((unsigned)b) << 16); }
DI float sigm(float x) { return __builtin_amdgcn_rcpf(1.f + __builtin_amdgcn_exp2f(-1.4426950408889634f * x)); }
DI float silu(float x) { return x * sigm(x); }
DI f32x4 mfma16(bf16x8 a, bf16x8 b, f32x4 c) { return __builtin_amdgcn_mfma_f32_16x16x32_bf16(a, b, c, 0, 0, 0); }
DI f32x16 mfma32(bf16x8 a, bf16x8 b, f32x16 c) { return __builtin_amdgcn_mfma_f32_32x32x16_bf16(a, b, c, 0, 0, 0); }

DI int opaque_tid() { int t = threadIdx.x; asm volatile("" : "+v"(t)); return t; }

DI const float* xrow(const Params& p, int l, int b, int t) {
  if (t < CTXL) return (l == 0 ? p.ctx : (const float*)p.Xctx) + (size_t)(b * CTXL + t) * DM;
  return (l == 0 ? p.x : (const float*)p.out) + (size_t)(b * SEQ + (t - CTXL)) * DM;
}

DI void mod_partial_item(const Params& p, int item, char* smem) {
  float* sc = (float*)smem;
  float* red = sc + 320;
  const int l = item / 192, rem = item % 192, cc = rem >> 4, kc = rem & 15;
  const int tid = opaque_tid(), w = tid >> 6, lane = tid & 63;
  for (int i = tid; i < 320; i += 256) {
    const int s = i >> 6, k = kc * 64 + (i & 63);
    const float v = (s < 4) ? p.c[s * 1024 + k] : p.c_ctx[k];
    sc[i] = silu(v);
  }
  __syncthreads();
  const float* wp = p.w_mod + ((size_t)l * 1024 + kc * 64 + w * 16) * 3072 + cc * 256 + lane * 4;
  float4 wv[16];
#pragma unroll
  for (int i = 0; i < 16; ++i) wv[i] = *(const float4*)(wp + (size_t)i * 3072);
  float4 acc[5];
#pragma unroll
  for (int s = 0; s < 5; ++s) acc[s] = float4{0.f, 0.f, 0.f, 0.f};
#pragma unroll
  for (int i = 0; i < 16; ++i) {
#pragma unroll
    for (int s = 0; s < 5; ++s) {
      const float cv = sc[s * 64 + w * 16 + i];
      acc[s].x += cv * wv[i].x; acc[s].y += cv * wv[i].y; acc[s].z += cv * wv[i].z; acc[s].w += cv * wv[i].w;
    }
  }
#pragma unroll
  for (int s = 0; s < 5; ++s) *(float4*)(red + (w * 5 + s) * 256 + lane * 4) = acc[s];
  __syncthreads();
  {
    const int col = tid;
#pragma unroll
    for (int s = 0; s < 5; ++s) {
      const float v = red[(0 * 5 + s) * 256 + col] + red[(1 * 5 + s) * 256 + col] + red[(2 * 5 + s) * 256 + col] + red[(3 * 5 + s) * 256 + col];
      p.modp[(size_t)kc * 61440 + (size_t)(l * 5 + s) * 3072 + cc * 256 + col] = v;
    }
  }
  __syncthreads();
}

DI void mod_reduce_item(const Params& p, int item) {
  const int idx = item * 256 + opaque_tid();
  const int n = idx % 3072, l = idx / (5 * 3072);
  float v = p.b_mod[l * 3072 + n];
#pragma unroll
  for (int kc = 0; kc < 16; ++kc) v += p.modp[(size_t)kc * 61440 + idx];
  p.mod[idx] = v;
}

DI void rope_item(const Params& p) {
  for (int idx = opaque_tid(); idx < 1024; idx += 256) {
    int pos = idx >> 4, i = idx & 15;
    float freq = exp2f(-(float)i * (13.287712379549449f / 16.f));
    float ang = (float)pos * freq;
    float rev = ang * 0.15915494309189535f;
    rev -= floorf(rev);
    p.rope[idx * 2 + 0] = __builtin_amdgcn_cosf(rev);
    p.rope[idx * 2 + 1] = __builtin_amdgcn_sinf(rev);
  }
}

DI void transpose_tile(const float* __restrict__ src, int R, int C, bf16_t* __restrict__ dst, int dp, int r0, int c0, char* smem) {
  float (*tl)[65] = (float (*)[65])smem;
  const int tid = opaque_tid();
#pragma unroll
  for (int i = 0; i < 4; ++i) {
    int r = (tid >> 4) + 16 * i, c = (tid & 15) * 4;
    float4 v = *(const float4*)(src + (size_t)(r0 + r) * C + c0 + c);
    tl[r][c] = v.x; tl[r][c + 1] = v.y; tl[r][c + 2] = v.z; tl[r][c + 3] = v.w;
  }
  __syncthreads();
#pragma unroll
  for (int i = 0; i < 2; ++i) {
    int n = (tid >> 3) + 32 * i, k8 = (tid & 7) * 8;
    uint4 o;
    o.x = pack2(tl[k8][n], tl[k8 + 1][n]); o.y = pack2(tl[k8 + 2][n], tl[k8 + 3][n]);
    o.z = pack2(tl[k8 + 4][n], tl[k8 + 5][n]); o.w = pack2(tl[k8 + 6][n], tl[k8 + 7][n]);
    *(uint4*)(dst + (size_t)(c0 + n) * dp + r0 + k8) = o;
  }
  __syncthreads();
}

DI void norm_item(const Params& p, int l, int item) {
  const int tid = opaque_tid(); const int w = tid >> 6, lane = tid & 63;
  const int m = item * 4 + w;
  const int b = m / TOK, t = m % TOK;
  const float* src = xrow(p, l, b, t);
  const int s = (t < CTXL) ? 4 : b;
  const float* md = p.mod + (size_t)(l * 5 + s) * 3072;
  const float* g = p.norm_g + l * 1024;
  float4 v[4];
  float ss = 0.f;
#pragma unroll
  for (int i = 0; i < 4; ++i) {
    v[i] = *(const float4*)(src + (i * 64 + lane) * 4);
    ss += v[i].x * v[i].x + v[i].y * v[i].y + v[i].z * v[i].z + v[i].w * v[i].w;
  }
#pragma unroll
  for (int off = 32; off >= 1; off >>= 1) ss += __shfl_xor(ss, off);
  const float rstd = rsqrtf(ss * (1.f / 1024.f) + 1e-6f);
  bf16_t* dst = p.Hs + (size_t)m * HP;
#pragma unroll
  for (int i = 0; i < 4; ++i) {
    int k = (i * 64 + lane) * 4;
    float4 gg = *(const float4*)(g + k), sh = *(const float4*)(md + k), scl = *(const float4*)(md + 1024 + k);
    float h0 = v[i].x * rstd * gg.x * (1.f + scl.x) + sh.x;
    float h1 = v[i].y * rstd * gg.y * (1.f + scl.y) + sh.y;
    float h2 = v[i].z * rstd * gg.z * (1.f + scl.z) + sh.z;
    float h3 = v[i].w * rstd * gg.w * (1.f + scl.w) + sh.w;
    uint2 o; o.x = pack2(h0, h1); o.y = pack2(h2, h3);
    *(uint2*)(dst + k) = o;
  }
}

DI void norm_run(const Params& p, int l, int i0, int nb, int n_items) {
  if (i0 >= n_items) return;
  const int tid = opaque_tid(); const int w = tid >> 6, lane = tid & 63;
  const float* g = p.norm_g + l * 1024;
  float4 gg[4];
#pragma unroll
  for (int i = 0; i < 4; ++i) gg[i] = *(const float4*)(g + (i * 64 + lane) * 4);
  float4 v[4], vn[4];
  {
    const int m = i0 * 4 + w;
    const float* src = xrow(p, l, m / TOK, m % TOK);
#pragma unroll
    for (int i = 0; i < 4; ++i) v[i] = *(const float4*)(src + (i * 64 + lane) * 4);
  }
  for (int it = i0; it < n_items; it += nb) {
    const int m = it * 4 + w;
    const int b = m / TOK, t = m % TOK;
    const bool more = it + nb < n_items;
    if (more) {
      const int m2 = (it + nb) * 4 + w;
      const float* src2 = xrow(p, l, m2 / TOK, m2 % TOK);
#pragma unroll
      for (int i = 0; i < 4; ++i) vn[i] = *(const float4*)(src2 + (i * 64 + lane) * 4);
    }
    const float* md = p.mod + (size_t)(l * 5 + ((t < CTXL) ? 4 : b)) * 3072;
    float ss = 0.f;
#pragma unroll
    for (int i = 0; i < 4; ++i) ss += v[i].x * v[i].x + v[i].y * v[i].y + v[i].z * v[i].z + v[i].w * v[i].w;
#pragma unroll
    for (int off = 32; off >= 1; off >>= 1) ss += __shfl_xor(ss, off);
    const float rstd = rsqrtf(ss * (1.f / 1024.f) + 1e-6f);
    bf16_t* dst = p.Hs + (size_t)m * HP;
#pragma unroll
    for (int i = 0; i < 4; ++i) {
      const int k = (i * 64 + lane) * 4;
      const float4 sh = *(const float4*)(md + k), scl = *(const float4*)(md + 1024 + k);
      const float h0 = v[i].x * rstd * gg[i].x * (1.f + scl.x) + sh.x;
      const float h1 = v[i].y * rstd * gg[i].y * (1.f + scl.y) + sh.y;
      const float h2 = v[i].z * rstd * gg[i].z * (1.f + scl.z) + sh.z;
      const float h3 = v[i].w * rstd * gg[i].w * (1.f + scl.w) + sh.w;
      uint2 o; o.x = pack2(h0, h1); o.y = pack2(h2, h3);
      *(uint2*)(dst + k) = o;
    }
    if (more) {
#pragma unroll
      for (int i = 0; i < 4; ++i) v[i] = vn[i];
    }
  }
}

template <int KK0, int KK1>
DI void gemm_compute(const bf16_t (*As)[128][64], const bf16_t (*Bs)[128][64], int cur, int wm, int wn, int fr, int fq,
                     f32x4 (&acc)[4][4]) {
  const int sw = (fr >> 1) & 7;
#pragma unroll
  for (int kk = KK0; kk < KK1; ++kk) {
    bf16x8 af[4], bfr[4];
#pragma unroll
    for (int i = 0; i < 4; ++i) af[i] = *(const bf16x8*)&As[cur][64 * wm + 16 * i + fr][((4 * kk + fq) ^ sw) * 8];
#pragma unroll
    for (int j = 0; j < 4; ++j) bfr[j] = *(const bf16x8*)&Bs[cur][64 * wn + 16 * j + fr][((4 * kk + fq) ^ sw) * 8];
#pragma unroll
    for (int i = 0; i < 4; ++i)
#pragma unroll
      for (int j = 0; j < 4; ++j) acc[i][j] = mfma16(bfr[j], af[i], acc[i][j]);
  }
}

DI void gemm_mainloop(const bf16_t* __restrict__ A, int lda, const bf16_t* __restrict__ Bt, int ldb, int m0, int n0, int K,
                      f32x4 (&acc)[4][4], char* smem, bool primed = false, const bf16_t* nA = nullptr, int nm0 = 0,
                      const bf16_t* nB = nullptr, int nn0 = 0) {
  typedef bf16_t (*tile_t)[128][64];
  tile_t As = (tile_t)smem;
  tile_t Bs = (tile_t)(smem + 2 * 128 * 64 * 2);
  const int tid = opaque_tid(), w = tid >> 6, lane = tid & 63, wm = w >> 1, wn = w & 1;
  const int fr = lane & 15, fq = lane >> 4;
  const int lrow = lane >> 3;
  const int ce = ((lane & 7) ^ (lane >> 4)) * 8;
  const int co = ((lane & 7) ^ (4 + (lane >> 4))) * 8;
  const bf16_t* ap0 = A + (size_t)(m0 + 32 * w + lrow) * lda;
  const bf16_t* bp0 = Bt + (size_t)(n0 + 32 * w + lrow) * ldb;
  const bf16_t* ap[4] = {ap0 + ce, ap0 + (size_t)8 * lda + co, ap0 + (size_t)16 * lda + ce, ap0 + (size_t)24 * lda + co};
  const bf16_t* bp[4] = {bp0 + ce, bp0 + (size_t)8 * ldb + co, bp0 + (size_t)16 * ldb + ce, bp0 + (size_t)24 * ldb + co};
#define GLDS1(BUF, KT, I) \
  __builtin_amdgcn_global_load_lds((const unsigned*)(ap[I] + (KT) * 64), (unsigned*)&As[BUF][32 * w + 8 * (I)][0], 16, 0, 0); \
  __builtin_amdgcn_global_load_lds((const unsigned*)(bp[I] + (KT) * 64), (unsigned*)&Bs[BUF][32 * w + 8 * (I)][0], 16, 0, 0);
#define GLDS(BUF, KT) { GLDS1(BUF, KT, 0) GLDS1(BUF, KT, 1) GLDS1(BUF, KT, 2) GLDS1(BUF, KT, 3) }
  const int nt = K >> 6;
  if (!primed) {
    GLDS(0, 0)
    GLDS(1, 1)
  }
  const bool hasnext = nA != nullptr;
  const int sw = (fr >> 1) & 7;
#define NGLDS(BUF) { \
    const bf16_t* na0 = nA + (size_t)(nm0 + 32 * w + lrow) * lda + (BUF) * 64; \
    const bf16_t* nb0 = nB + (size_t)(nn0 + 32 * w + lrow) * ldb + (BUF) * 64; \
    __builtin_amdgcn_global_load_lds((const unsigned*)(na0 + ce), (unsigned*)&As[BUF][32 * w + 0][0], 16, 0, 0); \
    __builtin_amdgcn_global_load_lds((const unsigned*)(nb0 + ce), (unsigned*)&Bs[BUF][32 * w + 0][0], 16, 0, 0); \
    __builtin_amdgcn_global_load_lds((const unsigned*)(na0 + (size_t)8 * lda + co), (unsigned*)&As[BUF][32 * w + 8][0], 16, 0, 0); \
    __builtin_amdgcn_global_load_lds((const unsigned*)(nb0 + (size_t)8 * ldb + co), (unsigned*)&Bs[BUF][32 * w + 8][0], 16, 0, 0); \
    __builtin_amdgcn_global_load_lds((const unsigned*)(na0 + (size_t)16 * lda + ce), (unsigned*)&As[BUF][32 * w + 16][0], 16, 0, 0); \
    __builtin_amdgcn_global_load_lds((const unsigned*)(nb0 + (size_t)16 * ldb + ce), (unsigned*)&Bs[BUF][32 * w + 16][0], 16, 0, 0); \
    __builtin_amdgcn_global_load_lds((const unsigned*)(na0 + (size_t)24 * lda + co), (unsigned*)&As[BUF][32 * w + 24][0], 16, 0, 0); \
    __builtin_amdgcn_global_load_lds((const unsigned*)(nb0 + (size_t)24 * ldb + co), (unsigned*)&Bs[BUF][32 * w + 24][0], 16, 0, 0); }
#define GTILE(BUF, KT2, MORE)                                                                                         \
  {                                                                                                                   \
    bf16x8 a0[4], b0[4], a1[4], b1[4];                                                                                \
    const int pc0 = ((0 + fq) ^ sw) * 8, pc1 = ((4 + fq) ^ sw) * 8;                                                   \
    _Pragma("unroll") for (int i = 0; i < 4; ++i) a0[i] = *(const bf16x8*)&As[BUF][64 * wm + 16 * i + fr][pc0];       \
    _Pragma("unroll") for (int j = 0; j < 4; ++j) b0[j] = *(const bf16x8*)&Bs[BUF][64 * wn + 16 * j + fr][pc0];       \
    _Pragma("unroll") for (int i = 0; i < 4; ++i) a1[i] = *(const bf16x8*)&As[BUF][64 * wm + 16 * i + fr][pc1];       \
    _Pragma("unroll") for (int j = 0; j < 4; ++j) b1[j] = *(const bf16x8*)&Bs[BUF][64 * wn + 16 * j + fr][pc1];       \
    asm volatile("s_waitcnt lgkmcnt(0)" ::: "memory");                                                                \
    __builtin_amdgcn_s_barrier();                              \
    if (MORE) GLDS(BUF, KT2) else if (hasnext) NGLDS(BUF)                                                             \
    _Pragma("unroll") for (int i = 0; i < 4; ++i)                                                                     \
      _Pragma("unroll") for (int j = 0; j < 4; ++j) acc[i][j] = mfma16(b0[j], a0[i], acc[i][j]);                      \
    _Pragma("unroll") for (int i = 0; i < 4; ++i)                                                                     \
      _Pragma("unroll") for (int j = 0; j < 4; ++j) acc[i][j] = mfma16(b1[j], a1[i], acc[i][j]);                      \
  }
  for (int t = 0; t < nt; t += 2) {
    const bool more = t + 2 < nt;
    asm volatile("s_waitcnt vmcnt(8)" ::: "memory");
    __builtin_amdgcn_s_barrier();
    GTILE(0, t + 2, more)
    if (more || hasnext) asm volatile("s_waitcnt vmcnt(8)" ::: "memory"); else asm volatile("s_waitcnt vmcnt(0)" ::: "memory");
    __builtin_amdgcn_s_barrier();
    GTILE(1, t + 3, more)
  }
#undef GTILE
#undef NGLDS
#undef GLDS
#undef GLDS1
}

DI void zero_acc(f32x4 (&acc)[4][4]) {
#pragma unroll
  for (int i = 0; i < 4; ++i)
#pragma unroll
    for (int j = 0; j < 4; ++j) acc[i][j] = f32x4{0.f, 0.f, 0.f, 0.f};
}

DI void g1_tile(const Params& p, int item, char* smem, bool primed = false, int next_item = -1) {
  const int mt = item / 52, nt = item % 52;
  const bf16_t* A = p.Hs;
  f32x4 acc[4][4];
  zero_acc(acc);
  if (next_item >= 0)
    gemm_mainloop(A, HP, p.Wt_in, HP, mt * 128, nt * 128, 1024, acc, smem, primed, A, (next_item / 52) * 128, p.Wt_in, (next_item % 52) * 128);
  else
    gemm_mainloop(A, HP, p.Wt_in, HP, mt * 128, nt * 128, 1024, acc, smem, primed);
  const int tid = opaque_tid(), w = tid >> 6, lane = tid & 63, wm = w >> 1, wn = w & 1;
  const int mbase = mt * 128 + 64 * wm + (lane & 15);
  const int nbase = nt * 128 + 64 * wn + 4 * (lane >> 4);
#pragma unroll
  for (int i = 0; i < 4; ++i)
#pragma unroll
    for (int j = 0; j < 4; ++j) {
      uint2 o; o.x = pack2(acc[i][j][0], acc[i][j][1]); o.y = pack2(acc[i][j][2], acc[i][j][3]);
      *(uint2*)(p.P + (size_t)(mbase + 16 * i) * DIN + nbase + 16 * j) = o;
    }
}

DI void g2_tile(const Params& p, int mt, int nt, char* smem, bool dry, bool primed = false, int nmt = -1, int nnt = 0) {
  f32x4 acc[4][4];
  const int tid = opaque_tid(), w = tid >> 6, lane = tid & 63, wm = w >> 1, wn = w & 1;
  const int mbase = mt * 128 + 64 * wm + (lane & 15);
  const int nbase = nt * 128 + 64 * wn + 4 * (lane >> 4);
  zero_acc(acc);
  gemm_mainloop(p.P + C_Q, DIN, p.Wt_abo, HP, mt * 128, nt * 128, 1024, acc, smem, primed, p.P + C_GB, mt * 128, p.Wt_abo + 1024 * HP, nt * 128);
#pragma unroll
  for (int i = 0; i < 4; ++i)
#pragma unroll
    for (int j = 0; j < 4; ++j) {
      bf16_t* pr = p.P + (size_t)(mbase + 16 * i) * DIN + C_GM + nbase + 16 * j;
      uint2 g = *(const uint2*)pr;
      uint2 o;
      o.x = pack2(acc[i][j][0] * sigm(bflo(g.x)), acc[i][j][1] * sigm(bfhi(g.x)));
      o.y = pack2(acc[i][j][2] * sigm(bflo(g.y)), acc[i][j][3] * sigm(bfhi(g.y)));
      if (!dry) *(uint2*)pr = o;
    }
  zero_acc(acc);
  if (nmt >= 0)
    gemm_mainloop(p.P + C_GB, DIN, p.Wt_abo + 1024 * HP, HP, mt * 128, nt * 128, 1024, acc, smem, true, p.P + C_Q, nmt * 128, p.Wt_abo, nnt * 128);
  else
    gemm_mainloop(p.P + C_GB, DIN, p.Wt_abo + 1024 * HP, HP, mt * 128, nt * 128, 1024, acc, smem, true);
#pragma unroll
  for (int i = 0; i < 4; ++i)
#pragma unroll
    for (int j = 0; j < 4; ++j) {
      bf16_t* pr = p.P + (size_t)(mbase + 16 * i) * DIN + C_GM + nbase + 16 * j;
      uint2 g = *(const uint2*)(pr + 1024);
      uint2 zp = *(const uint2*)pr;
      float z0 = bflo(zp.x) + acc[i][j][0] * sigm(bflo(g.x)), z1 = bfhi(zp.x) + acc[i][j][1] * sigm(bfhi(g.x));
      float z2 = bflo(zp.y) + acc[i][j][2] * sigm(bflo(g.y)), z3 = bfhi(zp.y) + acc[i][j][3] * sigm(bfhi(g.y));
      uint2 o; o.x = pack2(z0, z1); o.y = pack2(z2, z3);
      if (!dry) *(uint2*)pr = o;
    }
}

DI void g3_tile(const Params& p, int l, int mt, int nt, char* smem, bool dry, bool primed = false, int nmt = -1, int nnt = 0) {
  f32x4 acc[4][4];
  zero_acc(acc);
  if (nmt >= 0)
    gemm_mainloop(p.P + C_GM, DIN, p.Wt_abo + 2 * 1024 * HP, HP, mt * 128, nt * 128, 1024, acc, smem, primed, p.P + C_GM, nmt * 128, p.Wt_abo + 2 * 1024 * HP, nnt * 128);
  else
    gemm_mainloop(p.P + C_GM, DIN, p.Wt_abo + 2 * 1024 * HP, HP, mt * 128, nt * 128, 1024, acc, smem, primed);
  const int tid = opaque_tid(), w = tid >> 6, lane = tid & 63, wm = w >> 1, wn = w & 1;
  const int mbase = mt * 128 + 64 * wm + (lane & 15);
  const int nbase = nt * 128 + 64 * wn + 4 * (lane >> 4);
  const int b = (mt * 128) / TOK;
  const int tt0 = (mt * 128) % TOK;
  const int s = (tt0 < CTXL) ? 4 : b;
  const float* gt = p.mod + (size_t)(l * 5 + s) * 3072 + 2048;
#pragma unroll
  for (int i = 0; i < 4; ++i) {
    const int m = mbase + 16 * i;
    const int t = m - b * TOK;
    const float* xs = xrow(p, l, b, t);
    float* xd = (t < CTXL) ? (p.Xctx + (size_t)(b * CTXL + t) * DM) : (p.out + (size_t)(b * SEQ + (t - CTXL)) * DM);
#pragma unroll
    for (int j = 0; j < 4; ++j) {
      const int n = nbase + 16 * j;
      float4 xv = *(const float4*)(xs + n);
      float4 gv = *(const float4*)(gt + n);
      float4 o;
      o.x = xv.x + gv.x * acc[i][j][0]; o.y = xv.y + gv.y * acc[i][j][1];
      o.z = xv.z + gv.z * acc[i][j][2]; o.w = xv.w + gv.w * acc[i][j][3];
      if (!dry) *(float4*)(xd + n) = o;
    }
  }
}

DI void qk_finish(const uint2 (&u)[4], bf16_t* base, const float* g, const float* rope, bool lat, int rowp, int colp, int j4,
                  float sc, bool dry) {
  float v[4][4];
  float ss = 0.f;
#pragma unroll
  for (int qq = 0; qq < 4; ++qq) {
    v[qq][0] = bflo(u[qq].x); v[qq][1] = bfhi(u[qq].x); v[qq][2] = bflo(u[qq].y); v[qq][3] = bfhi(u[qq].y);
    ss += v[qq][0] * v[qq][0] + v[qq][1] * v[qq][1] + v[qq][2] * v[qq][2] + v[qq][3] * v[qq][3];
  }
  ss += __shfl_xor(ss, 1);
  ss += __shfl_xor(ss, 2);
  const float rstd = rsqrtf(ss * (1.f / 64.f) + 1e-6f);
#pragma unroll
  for (int qq = 0; qq < 4; ++qq)
#pragma unroll
    for (int e = 0; e < 4; ++e) v[qq][e] = v[qq][e] * rstd * g[16 * qq + e];
  if (lat) {
#pragma unroll
    for (int e = 0; e < 4; ++e) {
      const int fi = 4 * j4 + e;
      float2 cr = *(const float2*)(rope + (rowp * 16 + fi) * 2);
      float2 cc = *(const float2*)(rope + (colp * 16 + fi) * 2);
      float a0 = v[0][e], a1 = v[1][e], a2 = v[2][e], a3 = v[3][e];
      v[0][e] = a0 * cr.x - a1 * cr.y; v[1][e] = a1 * cr.x + a0 * cr.y;
      v[2][e] = a2 * cc.x - a3 * cc.y; v[3][e] = a3 * cc.x + a2 * cc.y;
    }
  }
#pragma unroll
  for (int qq = 0; qq < 4; ++qq) {
    uint2 o; o.x = pack2(v[qq][0] * sc, v[qq][1] * sc); o.y = pack2(v[qq][2] * sc, v[qq][3] * sc);
    if (!dry) *(uint2*)(base + 16 * qq) = o;
  }
}

DI void qk_item(const Params& p, int l, int tile, bool dry) {
  const int tid = opaque_tid(), w = tid >> 6, lane = tid & 63;
  const int m0 = tile * 32;
  const int t0 = m0 % TOK;
  const int hd = lane >> 2, j4 = lane & 3;
  const float* gq = p.q_norm_g + l * 64 + 4 * j4;
  const float* gk = p.k_norm_g + l * 64 + 4 * j4;
  for (int tt = 0; tt < 8; tt += 2) {
    uint2 uq[2][4], uk[2][4];
#pragma unroll
    for (int x = 0; x < 2; ++x) {
      const size_t m = (size_t)m0 + 8 * w + tt + x;
      const bf16_t* qb = p.P + m * DIN + C_Q + hd * 64 + 4 * j4;
      const bf16_t* kb = p.P + m * DIN + C_K + (hd & 3) * 64 + 4 * j4;
#pragma unroll
      for (int qq = 0; qq < 4; ++qq) { uq[x][qq] = *(const uint2*)(qb + 16 * qq); uk[x][qq] = *(const uint2*)(kb + 16 * qq); }
    }
#pragma unroll
    for (int x = 0; x < 2; ++x) {
      const int tok = 8 * w + tt + x;
      const size_t m = (size_t)m0 + tok;
      const int t = t0 + tok;
      const bool lat = t >= CTXL;
      const int nn = t - CTXL;
      const int rowp = (nn >> 6) & 63, colp = nn & 63;
      qk_finish(uq[x], p.P + m * DIN + C_Q + hd * 64 + 4 * j4, gq, p.rope, lat, rowp, colp, j4, 0.125f * 1.4426950408889634f, dry);
      if (lane < 16) qk_finish(uk[x], p.P + m * DIN + C_K + hd * 64 + 4 * j4, gk, p.rope, lat, rowp, colp, j4, 1.f, dry);
    }
  }
}

DI void vt_item(const Params& p, int tile, char* smem, bool dry) {
  const int tid = opaque_tid();
  const int m0 = tile * 64;
  bf16_t* vs = (bf16_t*)smem;
#pragma unroll
  for (int i = 0; i < 8; ++i) {
    int c = tid + 256 * i;
    int tok = c >> 5, cc = c & 31;
    uint4 v = *(const uint4*)(p.P + (size_t)(m0 + tok) * DIN + C_V + cc * 8);
    *(uint4*)(vs + tok * 264 + cc * 8) = v;
  }
  __syncthreads();
  {
    const int R = tid;
    bf16_t* dst = p.P + (size_t)(m0 + (R >> 2)) * DIN + C_V + (R & 3) * 64;
#pragma unroll
    for (int c8 = 0; c8 < 8; ++c8) {
      uint4 o;
      const int sa = (2 * c8) & 3, sb = (2 * c8 + 1) & 3;
      const int ta = ((c8 * 8) & ~12) | ((sa == 1 ? 2 : (sa == 2 ? 1 : sa)) << 2);
      const int tb = ((c8 * 8 + 4) & ~12) | ((sb == 1 ? 2 : (sb == 2 ? 1 : sb)) << 2);
      unsigned e0 = vs[(ta + 0) * 264 + R], e1 = vs[(ta + 1) * 264 + R], e2 = vs[(ta + 2) * 264 + R], e3 = vs[(ta + 3) * 264 + R];
      unsigned e4 = vs[(tb + 0) * 264 + R], e5 = vs[(tb + 1) * 264 + R], e6 = vs[(tb + 2) * 264 + R], e7 = vs[(tb + 3) * 264 + R];
      o.x = e0 | (e1 << 16); o.y = e2 | (e3 << 16); o.z = e4 | (e5 << 16); o.w = e6 | (e7 << 16);
      if (!dry) *(uint4*)(dst + c8 * 8) = o;
    }
  }
  __syncthreads();
}

DI float fold_range(const float2* ag, int first, int count, int step, float h) {
  for (int base = 0; base < count; base += 16) {
    float2 v[16];
#pragma unroll
    for (int i = 0; i < 16; ++i) {
      const int k = base + i;
      const int c = first + step * (k < count ? k : count - 1);
      v[i] = ag[(size_t)c * 1024];
    }
#pragma unroll
    for (int i = 0; i < 16; ++i) if (base + i < count) h = v[i].x * h + v[i].y;
  }
  return h;
}

DI void lru_item(const Params& p, int l, int b, int chunk, int blk, int pass, char* smem, bool dry) {
  const int item_index = (b * NCHUNK + chunk) * 16 + blk;
  float* ucf = (float*)smem;
  bf16_t* ucb = (bf16_t*)(smem + 16384);
  bf16_t* us = (bf16_t*)(smem + 25600);
  float* ybuf = (float*)(smem + 34304);
  const int tid = opaque_tid(), w = tid >> 6, lane = tid & 63, r = lane & 31, hh = lane >> 5;
  const int t0 = chunk * 64;
  const size_t rowbase = (size_t)b * TOK;
  const int seg_lo = (t0 < CTXL) ? 0 : CTXL, seg_hi = (t0 < CTXL) ? CTXL : TOK;
  const int dir = w >> 1, chh = w & 1;
  const int jj = 32 * chh + r;
  const int gch = blk * 64 + jj;

  float hin = 0.f;
  if (pass == 2) {
    const float2* ag = (const float2*)p.agg + ((size_t)(b * 2 + dir) * NCHUNK) * 1024 + gch;
    if (dir == 0) {
      hin = fold_range(ag, 0, chunk, 1, hin);
    } else if (chunk < 4) {
      hin = fold_range(ag, 3, 3 - chunk, -1, hin);
    } else {
      hin = fold_range(ag, 3, 4, -1, hin);
      hin = fold_range(ag, NCHUNK - 1, NCHUNK - 1 - chunk, -1, hin);
    }
  }
  f32x16 ar[2], ai[2];
#pragma unroll
  for (int T = 0; T < 2; ++T)
#pragma unroll
    for (int i = 0; i < 16; ++i) { ar[T][i] = 0.f; ai[T][i] = 0.f; }
  bf16_t* labp = p.lab + (size_t)item_index * 16384 + dir * 8192 + jj * 64;
  if (pass == 1) {
    bf16x8 wbr[4], wbi[4];
    {
      const bf16_t* gw = p.Wg + (size_t)((dir * 2 + 0) * 16 + blk) * 4096 + jj * 64 + 8 * hh;
  #pragma unroll
      for (int s = 0; s < 4; ++s) { wbr[s] = *(const bf16x8*)(gw + 16 * s); wbi[s] = *(const bf16x8*)(gw + 16 * 4096 + 16 * s); }
    }
    const float brr = p.gate_b[((l * 2 + dir) * 2 + 0) * 1024 + gch];
    const float bii = p.gate_b[((l * 2 + dir) * 2 + 1) * 1024 + gch];
    const float xl = -p.lam[(l * 2 + dir) * 1024 + gch];

    for (int c = tid; c < 67 * 8; c += 256) {
      int rr = c >> 3, kc = c & 7;
      int t = t0 - 2 + rr;
      uint4 v = uint4{0u, 0u, 0u, 0u};
      if (t >= seg_lo && t < seg_hi) v = *(const uint4*)(p.P + (rowbase + t) * DIN + C_U + blk * 64 + kc * 8);
      *(uint4*)(us + rr * 64 + kc * 8) = v;
    }
    __syncthreads();
    {
      const int ch = tid & 63, tg = tid >> 6;
      const float* cw = p.conv_w + (size_t)l * 4 * 1024 + blk * 64 + ch;
      const float w0 = cw[0], w1 = cw[1024], w2 = cw[2048], w3 = cw[3072];
      const float cb = p.conv_b[l * 1024 + blk * 64 + ch];
      float x0 = bf2f(us[(16 * tg + 0) * 64 + ch]), x1 = bf2f(us[(16 * tg + 1) * 64 + ch]), x2 = bf2f(us[(16 * tg + 2) * 64 + ch]);
  #pragma unroll
      for (int i = 0; i < 16; ++i) {
        float x3 = bf2f(us[(16 * tg + i + 3) * 64 + ch]);
        float o = x0 * w0;
        o += x1 * w1; o += x2 * w2; o += x3 * w3; o += cb;
        const int tok = 16 * tg + i;
        ucf[tok * 64 + ch] = o;
        ucb[tok * 72 + ch] = (bf16_t)f2bf(o);
        x0 = x1; x1 = x2; x2 = x3;
      }
    }
    __syncthreads();
    {
  #pragma unroll
      for (int s = 0; s < 4; ++s) {
        const bf16x8 br = wbr[s];
        const bf16x8 bi = wbi[s];
  #pragma unroll
        for (int T = 0; T < 2; ++T) {
          bf16x8 a = *(const bf16x8*)(ucb + (32 * T + r) * 72 + 16 * s + 8 * hh);
          ar[T] = mfma32(a, br, ar[T]);
          ai[T] = mfma32(a, bi, ai[T]);
        }
      }
    }
    {
      const float sp = fmaxf(xl, 0.f) + log1pf(expf(-fabsf(xl)));
  #pragma unroll
      for (int T = 0; T < 2; ++T)
  #pragma unroll
        for (int half = 0; half < 2; ++half) {
          float lv[8], bv[8];
  #pragma unroll
          for (int e = 0; e < 8; ++e) {
            const int reg = 8 * half + e;
            const int t = 32 * T + (reg & 3) + 8 * (reg >> 2) + 4 * hh;
            const float ucv = ucf[t * 64 + jj];
            const float rg = sigm(ar[T][reg] + brr);
            const float ig = sigm(ai[T][reg] + bii);
            const float la2 = (-8.f * 1.4426950408889634f) * rg * sp;
            const float a = __builtin_amdgcn_exp2f(la2);
            lv[e] = la2;
            bv[e] = __builtin_amdgcn_sqrtf(fmaxf(1.f - a * a, 0.f)) * (ig * ucv);
          }
          uint4 pl, pbv;
          pl.x = pack2(lv[0], lv[1]); pl.y = pack2(lv[2], lv[3]); pl.z = pack2(lv[4], lv[5]); pl.w = pack2(lv[6], lv[7]);
          pbv.x = pack2(bv[0], bv[1]); pbv.y = pack2(bv[2], bv[3]); pbv.z = pack2(bv[4], bv[5]); pbv.w = pack2(bv[6], bv[7]);
          {
            bf16_t* lp = labp + 32 * T + 16 * half + 4 * hh;
            *(uint2*)(lp) = uint2{pl.x, pl.y};
            *(uint2*)(lp + 8) = uint2{pl.z, pl.w};
            *(uint2*)(lp + 4096) = uint2{pbv.x, pbv.y};
            *(uint2*)(lp + 4096 + 8) = uint2{pbv.z, pbv.w};
          }
          ar[T][8 * half + 0] = __builtin_amdgcn_exp2f(bflo(pl.x)); ar[T][8 * half + 1] = __builtin_amdgcn_exp2f(bfhi(pl.x));
          ar[T][8 * half + 2] = __builtin_amdgcn_exp2f(bflo(pl.y)); ar[T][8 * half + 3] = __builtin_amdgcn_exp2f(bfhi(pl.y));
          ar[T][8 * half + 4] = __builtin_amdgcn_exp2f(bflo(pl.z)); ar[T][8 * half + 5] = __builtin_amdgcn_exp2f(bfhi(pl.z));
          ar[T][8 * half + 6] = __builtin_amdgcn_exp2f(bflo(pl.w)); ar[T][8 * half + 7] = __builtin_amdgcn_exp2f(bfhi(pl.w));
          ai[T][8 * half + 0] = bflo(pbv.x); ai[T][8 * half + 1] = bfhi(pbv.x); ai[T][8 * half + 2] = bflo(pbv.y); ai[T][8 * half + 3] = bfhi(pbv.y);
          ai[T][8 * half + 4] = bflo(pbv.z); ai[T][8 * half + 5] = bfhi(pbv.z); ai[T][8 * half + 6] = bflo(pbv.w); ai[T][8 * half + 7] = bfhi(pbv.w);
        }
    }
  }
  float cA[8], cB[8];
#pragma unroll
  for (int k = 0; k < 8; ++k) {
    const int T = k >> 2, g = k & 3;
    float A = 1.f, B = 0.f;
    if (dir == 0) {
#pragma unroll
      for (int e = 0; e < 4; ++e) { float a = ar[T][4 * g + e]; B = a * B + ai[T][4 * g + e]; A *= a; }
    } else {
#pragma unroll
      for (int e = 3; e >= 0; --e) { float a = ar[T][4 * g + e]; B = a * B + ai[T][4 * g + e]; A *= a; }
    }
    cA[k] = A; cB[k] = B;
  }
  float loA[8], loB[8], hiA[8], hiB[8];
#pragma unroll
  for (int k = 0; k < 8; ++k) {
    float pA = __shfl_xor(cA[k], 32), pB = __shfl_xor(cB[k], 32);
    loA[k] = hh ? pA : cA[k]; loB[k] = hh ? pB : cB[k];
    hiA[k] = hh ? cA[k] : pA; hiB[k] = hh ? cB[k] : pB;
  }
  if (pass == 1) {
    float A = 1.f, B = 0.f;
    if (dir == 0) {
#pragma unroll
      for (int k = 0; k < 8; ++k) { B = loA[k] * B + loB[k]; A *= loA[k]; B = hiA[k] * B + hiB[k]; A *= hiA[k]; }
    } else {
#pragma unroll
      for (int k = 7; k >= 0; --k) { B = hiA[k] * B + hiB[k]; A *= hiA[k]; B = loA[k] * B + loB[k]; A *= loA[k]; }
    }
    if (hh == 0) {
      float2* ag = (float2*)p.agg + ((size_t)(b * 2 + dir) * NCHUNK + chunk) * 1024 + gch;
      *ag = float2{A, B};
    }
    __syncthreads();
    return;
  }
  float st[8];
  {
    float h = hin;
    if (dir == 0) {
#pragma unroll
      for (int k = 0; k < 8; ++k) {
        float s_lo = h; h = loA[k] * h + loB[k];
        float s_hi = h; h = hiA[k] * h + hiB[k];
        st[k] = hh ? s_hi : s_lo;
      }
    } else {
#pragma unroll
      for (int k = 7; k >= 0; --k) {
        float s_hi = h; h = hiA[k] * h + hiB[k];
        float s_lo = h; h = loA[k] * h + loB[k];
        st[k] = hh ? s_hi : s_lo;
      }
    }
  }
#pragma unroll
  for (int k = 0; k < 8; ++k) {
    const int T = k >> 2, g = k & 3;
    float h = st[k];
    if (dir == 0) {
#pragma unroll
      for (int e = 0; e < 4; ++e) { h = ar[T][4 * g + e] * h + ai[T][4 * g + e]; ar[T][4 * g + e] = h; }
    } else {
#pragma unroll
      for (int e = 3; e >= 0; --e) { h = ar[T][4 * g + e] * h + ai[T][4 * g + e]; ar[T][4 * g + e] = h; }
    }
  }
  if (dir == 0) {
#pragma unroll
    for (int T = 0; T < 2; ++T)
#pragma unroll
      for (int reg = 0; reg < 16; ++reg) {
        const int t = 32 * T + (reg & 3) + 8 * (reg >> 2) + 4 * hh;
        ybuf[t * 64 + jj] = ar[T][reg];
      }
  }
  __syncthreads();
  if (dir == 1) {
#pragma unroll
    for (int T = 0; T < 2; ++T)
#pragma unroll
      for (int reg = 0; reg < 16; ++reg) {
        const int t = 32 * T + (reg & 3) + 8 * (reg >> 2) + 4 * hh;
        ybuf[t * 64 + jj] += ar[T][reg];
      }
  }
  __syncthreads();
  {
    const int tok = tid >> 2, cg4 = tid & 3;
    bf16_t* gp = p.P + (rowbase + t0 + tok) * DIN + C_GB + blk * 64 + cg4 * 16;
    const float* yp = ybuf + tok * 64 + cg4 * 16;
#pragma unroll
    for (int hq = 0; hq < 2; ++hq) {
      uint4 g = *(const uint4*)(gp + 8 * hq);
      uint4 o;
      o.x = pack2(yp[8 * hq + 0] * silu(bflo(g.x)), yp[8 * hq + 1] * silu(bfhi(g.x)));
      o.y = pack2(yp[8 * hq + 2] * silu(bflo(g.y)), yp[8 * hq + 3] * silu(bfhi(g.y)));
      o.z = pack2(yp[8 * hq + 4] * silu(bflo(g.z)), yp[8 * hq + 5] * silu(bfhi(g.z)));
      o.w = pack2(yp[8 * hq + 6] * silu(bflo(g.w)), yp[8 * hq + 7] * silu(bfhi(g.w)));
      if (!dry) *(uint4*)(gp + 8 * hq) = o;
    }
  }
  __syncthreads();
}

DI void lru1_run(const Params& p, int l, int j0, int nb, int n_l, char* smem) {
  if (j0 >= n_l) return;
  float* ucf = (float*)smem;
  bf16_t* ucb = (bf16_t*)(smem + 16384);
  bf16_t* us = (bf16_t*)(smem + 25600);
  typedef unsigned u32x4 __attribute__((ext_vector_type(4)));
  const int tid = opaque_tid(), w = tid >> 6, lane = tid & 63, r = lane & 31, hh = lane >> 5;
  const int dir = w >> 1, chh = w & 1;
  const int jj = 32 * chh + r;
  const int blk = j0 & 15;
  const int gch = blk * 64 + jj;
  bf16x8 wbr[4], wbi[4];
  {
    const bf16_t* gw = p.Wg + (size_t)((dir * 2 + 0) * 16 + blk) * 4096 + jj * 64 + 8 * hh;
#pragma unroll
    for (int s = 0; s < 4; ++s) { wbr[s] = *(const bf16x8*)(gw + 16 * s); wbi[s] = *(const bf16x8*)(gw + 16 * 4096 + 16 * s); }
  }
  const float brr = p.gate_b[((l * 2 + dir) * 2 + 0) * 1024 + gch];
  const float bii = p.gate_b[((l * 2 + dir) * 2 + 1) * 1024 + gch];
  const float xl = -p.lam[(l * 2 + dir) * 1024 + gch];
  const float sp = fmaxf(xl, 0.f) + log1pf(expf(-fabsf(xl)));
  const int cch = tid & 63, tg = tid >> 6;
  const float* cw = p.conv_w + (size_t)l * 4 * 1024 + blk * 64 + cch;
  const float w0 = cw[0], w1 = cw[1024], w2 = cw[2048], w3 = cw[3072];
  const float cb = p.conv_b[l * 1024 + blk * 64 + cch];
  u32x4 pu0, pu1, pu2;
#define LRU_LOADU(J) { \
    const int rest_ = (J) >> 4; const int chunk_ = rest_ % NCHUNK, b_ = rest_ / NCHUNK; const int t0_ = chunk_ * 64; \
    const int lo_ = (t0_ < CTXL) ? 0 : CTXL, hi_ = (t0_ < CTXL) ? CTXL : TOK; \
    const bf16_t* ub_ = p.P + ((size_t)b_ * TOK) * DIN + C_U + blk * 64; \
    { const int c_ = tid; const int t_ = t0_ - 2 + (c_ >> 3); pu0 = u32x4{0u, 0u, 0u, 0u}; if (t_ >= lo_ && t_ < hi_) pu0 = *(const u32x4*)(ub_ + (size_t)t_ * DIN + (c_ & 7) * 8); } \
    { const int c_ = tid + 256; const int t_ = t0_ - 2 + (c_ >> 3); pu1 = u32x4{0u, 0u, 0u, 0u}; if (t_ >= lo_ && t_ < hi_) pu1 = *(const u32x4*)(ub_ + (size_t)t_ * DIN + (c_ & 7) * 8); } \
    { const int c_ = tid + 512; const int t_ = t0_ - 2 + (c_ >> 3); pu2 = u32x4{0u, 0u, 0u, 0u}; if (c_ < 536 && t_ >= lo_ && t_ < hi_) pu2 = *(const u32x4*)(ub_ + (size_t)t_ * DIN + (c_ & 7) * 8); } }
  LRU_LOADU(j0)
  for (int j = j0; j < n_l; j += nb) {
    const int rest = j >> 4;
    const int chunk = rest % NCHUNK, b = rest / NCHUNK;
    const int item_index = (b * NCHUNK + chunk) * 16 + blk;
    *(u32x4*)(us + (tid >> 3) * 64 + (tid & 7) * 8) = pu0;
    *(u32x4*)(us + ((tid + 256) >> 3) * 64 + (tid & 7) * 8) = pu1;
    if (tid + 512 < 536) *(u32x4*)(us + ((tid + 512) >> 3) * 64 + (tid & 7) * 8) = pu2;
    __syncthreads();
    if (j + nb < n_l) LRU_LOADU(j + nb)
    {
      float x0 = bf2f(us[(16 * tg + 0) * 64 + cch]), x1 = bf2f(us[(16 * tg + 1) * 64 + cch]), x2 = bf2f(us[(16 * tg + 2) * 64 + cch]);
#pragma unroll
      for (int i = 0; i < 16; ++i) {
        float x3 = bf2f(us[(16 * tg + i + 3) * 64 + cch]);
        float o = x0 * w0;
        o += x1 * w1; o += x2 * w2; o += x3 * w3; o += cb;
        const int tok = 16 * tg + i;
        ucf[tok * 64 + cch] = o;
        ucb[tok * 72 + cch] = (bf16_t)f2bf(o);
        x0 = x1; x1 = x2; x2 = x3;
      }
    }
    __syncthreads();
    f32x16 ar[2], ai[2];
#pragma unroll
    for (int T = 0; T < 2; ++T)
#pragma unroll
      for (int i = 0; i < 16; ++i) { ar[T][i] = 0.f; ai[T][i] = 0.f; }
#pragma unroll
    for (int s = 0; s < 4; ++s)
#pragma unroll
      for (int T = 0; T < 2; ++T) {
        bf16x8 a = *(const bf16x8*)(ucb + (32 * T + r) * 72 + 16 * s + 8 * hh);
        ar[T] = mfma32(a, wbr[s], ar[T]);
        ai[T] = mfma32(a, wbi[s], ai[T]);
      }
    bf16_t* labp = p.lab + (size_t)item_index * 16384 + dir * 8192 + jj * 64;
#pragma unroll
    for (int T = 0; T < 2; ++T)
#pragma unroll
      for (int half = 0; half < 2; ++half) {
        float lv[8], bv[8];
#pragma unroll
        for (int e = 0; e < 8; ++e) {
          const int reg = 8 * half + e;
          const int t = 32 * T + (reg & 3) + 8 * (reg >> 2) + 4 * hh;
          const float ucv = ucf[t * 64 + jj];
          const float rg = sigm(ar[T][reg] + brr);
          const float ig = sigm(ai[T][reg] + bii);
          const float la2 = (-8.f * 1.4426950408889634f) * rg * sp;
          const float a = __builtin_amdgcn_exp2f(la2);
          lv[e] = la2;
          bv[e] = __builtin_amdgcn_sqrtf(fmaxf(1.f - a * a, 0.f)) * (ig * ucv);
        }
        uint4 pl, pbv;
        pl.x = pack2(lv[0], lv[1]); pl.y = pack2(lv[2], lv[3]); pl.z = pack2(lv[4], lv[5]); pl.w = pack2(lv[6], lv[7]);
        pbv.x = pack2(bv[0], bv[1]); pbv.y = pack2(bv[2], bv[3]); pbv.z = pack2(bv[4], bv[5]); pbv.w = pack2(bv[6], bv[7]);
        {
          bf16_t* lp = labp + 32 * T + 16 * half + 4 * hh;
          *(uint2*)(lp) = uint2{pl.x, pl.y};
          *(uint2*)(lp + 8) = uint2{pl.z, pl.w};
          *(uint2*)(lp + 4096) = uint2{pbv.x, pbv.y};
          *(uint2*)(lp + 4096 + 8) = uint2{pbv.z, pbv.w};
        }
        ar[T][8 * half + 0] = __builtin_amdgcn_exp2f(bflo(pl.x)); ar[T][8 * half + 1] = __builtin_amdgcn_exp2f(bfhi(pl.x));
        ar[T][8 * half + 2] = __builtin_amdgcn_exp2f(bflo(pl.y)); ar[T][8 * half + 3] = __builtin_amdgcn_exp2f(bfhi(pl.y));
        ar[T][8 * half + 4] = __builtin_amdgcn_exp2f(bflo(pl.z)); ar[T][8 * half + 5] = __builtin_amdgcn_exp2f(bfhi(pl.z));
        ar[T][8 * half + 6] = __builtin_amdgcn_exp2f(bflo(pl.w)); ar[T][8 * half + 7] = __builtin_amdgcn_exp2f(bfhi(pl.w));
        ai[T][8 * half + 0] = bflo(pbv.x); ai[T][8 * half + 1] = bfhi(pbv.x); ai[T][8 * half + 2] = bflo(pbv.y); ai[T][8 * half + 3] = bfhi(pbv.y);
        ai[T][8 * half + 4] = bflo(pbv.z); ai[T][8 * half + 5] = bfhi(pbv.z); ai[T][8 * half + 6] = bflo(pbv.w); ai[T][8 * half + 7] = bfhi(pbv.w);
      }
    float cA[8], cB[8];
#pragma unroll
    for (int k = 0; k < 8; ++k) {
      const int T = k >> 2, g = k & 3;
      float A = 1.f, B = 0.f;
      if (dir == 0) {
#pragma unroll
        for (int e = 0; e < 4; ++e) { float a = ar[T][4 * g + e]; B = a * B + ai[T][4 * g + e]; A *= a; }
      } else {
#pragma unroll
        for (int e = 3; e >= 0; --e) { float a = ar[T][4 * g + e]; B = a * B + ai[T][4 * g + e]; A *= a; }
      }
      cA[k] = A; cB[k] = B;
    }
    float A = 1.f, B = 0.f;
    if (dir == 0) {
#pragma unroll
      for (int k = 0; k < 8; ++k) {
        const float pA = __shfl_xor(cA[k], 32), pB = __shfl_xor(cB[k], 32);
        const float loA = hh ? pA : cA[k], loB = hh ? pB : cB[k], hiA = hh ? cA[k] : pA, hiB = hh ? cB[k] : pB;
        B = loA * B + loB; A *= loA; B = hiA * B + hiB; A *= hiA;
      }
    } else {
#pragma unroll
      for (int k = 7; k >= 0; --k) {
        const float pA = __shfl_xor(cA[k], 32), pB = __shfl_xor(cB[k], 32);
        const float loA = hh ? pA : cA[k], loB = hh ? pB : cB[k], hiA = hh ? cA[k] : pA, hiB = hh ? cB[k] : pB;
        B = hiA * B + hiB; A *= hiA; B = loA * B + loB; A *= loA;
      }
    }
    if (hh == 0) {
      float2* ag = (float2*)p.agg + ((size_t)(b * 2 + dir) * NCHUNK + chunk) * 1024 + gch;
      *ag = float2{A, B};
    }
    __syncthreads();
  }
#undef LRU_LOADU
}

DI void lru2_wave(const Params& p, int wi, bool last, bool dry) {
  const int lane = opaque_tid() & 63;
  const int blk = wi & 15, rest = wi >> 4;
  const int chunk = rest % NCHUNK, b = rest / NCHUNK;
  if (last && chunk < 4) return;
  const int gch = blk * 64 + lane;
  const float2* ag0 = (const float2*)p.agg + ((size_t)(b * 2 + 0) * NCHUNK) * 1024 + gch;
  const float2* ag1 = (const float2*)p.agg + ((size_t)(b * 2 + 1) * NCHUNK) * 1024 + gch;
  float hf = fold_range(ag0, 0, chunk, 1, 0.f);
  float hr = 0.f;
  if (chunk < 4) {
    hr = fold_range(ag1, 3, 3 - chunk, -1, hr);
  } else {
    hr = fold_range(ag1, 3, 4, -1, hr);
    hr = fold_range(ag1, NCHUNK - 1, NCHUNK - 1 - chunk, -1, hr);
  }
  const bf16_t* lp = p.lab + (size_t)wi * 16384 + lane * 64;
  float y[64];
  {
    uint4 la[8], bb[8];
#pragma unroll
    for (int q = 0; q < 8; ++q) { la[q] = *(const uint4*)(lp + q * 8); bb[q] = *(const uint4*)(lp + 4096 + q * 8); }
    float h = hf;
#pragma unroll
    for (int q = 0; q < 8; ++q) {
      h = __builtin_amdgcn_exp2f(bflo(la[q].x)) * h + bflo(bb[q].x); y[8 * q + 0] = h;
      h = __builtin_amdgcn_exp2f(bfhi(la[q].x)) * h + bfhi(bb[q].x); y[8 * q + 1] = h;
      h = __builtin_amdgcn_exp2f(bflo(la[q].y)) * h + bflo(bb[q].y); y[8 * q + 2] = h;
      h = __builtin_amdgcn_exp2f(bfhi(la[q].y)) * h + bfhi(bb[q].y); y[8 * q + 3] = h;
      h = __builtin_amdgcn_exp2f(bflo(la[q].z)) * h + bflo(bb[q].z); y[8 * q + 4] = h;
      h = __builtin_amdgcn_exp2f(bfhi(la[q].z)) * h + bfhi(bb[q].z); y[8 * q + 5] = h;
      h = __builtin_amdgcn_exp2f(bflo(la[q].w)) * h + bflo(bb[q].w); y[8 * q + 6] = h;
      h = __builtin_amdgcn_exp2f(bfhi(la[q].w)) * h + bfhi(bb[q].w); y[8 * q + 7] = h;
    }
  }
  {
    uint4 la[8], bb[8];
#pragma unroll
    for (int q = 0; q < 8; ++q) { la[q] = *(const uint4*)(lp + 8192 + q * 8); bb[q] = *(const uint4*)(lp + 8192 + 4096 + q * 8); }
    float h = hr;
#pragma unroll
    for (int q = 7; q >= 0; --q) {
      h = __builtin_amdgcn_exp2f(bfhi(la[q].w)) * h + bfhi(bb[q].w); y[8 * q + 7] += h;
      h = __builtin_amdgcn_exp2f(bflo(la[q].w)) * h + bflo(bb[q].w); y[8 * q + 6] += h;
      h = __builtin_amdgcn_exp2f(bfhi(la[q].z)) * h + bfhi(bb[q].z); y[8 * q + 5] += h;
      h = __builtin_amdgcn_exp2f(bflo(la[q].z)) * h + bflo(bb[q].z); y[8 * q + 4] += h;
      h = __builtin_amdgcn_exp2f(bfhi(la[q].y)) * h + bfhi(bb[q].y); y[8 * q + 3] += h;
      h = __builtin_amdgcn_exp2f(bflo(la[q].y)) * h + bflo(bb[q].y); y[8 * q + 2] += h;
      h = __builtin_amdgcn_exp2f(bfhi(la[q].x)) * h + bfhi(bb[q].x); y[8 * q + 1] += h;
      h = __builtin_amdgcn_exp2f(bflo(la[q].x)) * h + bflo(bb[q].x); y[8 * q + 0] += h;
    }
  }
  bf16_t* gp = p.P + ((size_t)b * TOK + (size_t)chunk * 64) * DIN + C_GB + blk * 64 + lane;
#pragma unroll
  for (int t0 = 0; t0 < 64; t0 += 16) {
    bf16_t g[16];
#pragma unroll
    for (int i = 0; i < 16; ++i) g[i] = gp[(size_t)(t0 + i) * DIN];
#pragma unroll
    for (int i = 0; i < 16; ++i) {
      const float o = y[t0 + i] * silu(bf2f(g[i]));
      if (!dry) gp[(size_t)(t0 + i) * DIN] = (bf16_t)f2bf(o);
    }
  }
}

template <bool FAST>
DI void attn_item_t(const Params& p, int b, int hq, int qt0, int nkeys, char* smem, bool dry) {
  typedef bf16_t (*kv_t)[64][72];
  kv_t Ks = (kv_t)smem;
  kv_t Vs = (kv_t)(smem + 2 * 64 * 72 * 2);
  const int tid = opaque_tid(), w = tid >> 6, lane = tid & 63, r = lane & 31, hh = lane >> 5;
  const int kvh = hq >> 2;
  const size_t rowbase = (size_t)b * TOK;
  const size_t mq = rowbase + qt0 + 32 * w + r;
  bf16_t* prow = p.P + mq * DIN;
  bf16x8 qf[4];
#pragma unroll
  for (int s = 0; s < 4; ++s) qf[s] = *(const bf16x8*)(prow + C_Q + hq * 64 + 16 * s + 8 * hh);
  const int lr = tid >> 3, lc = tid & 7;
  const bf16_t* kptr = p.P + (rowbase + lr) * DIN + C_K + kvh * 64 + lc * 8;
  const bf16_t* vptr = p.P + (rowbase + kvh * 16 + (lr >> 2)) * DIN + C_V + (lr & 3) * 64 + lc * 8;
  uint4 rk0, rk1, rv0, rv1;
  rk0 = *(const uint4*)(kptr); rk1 = *(const uint4*)(kptr + (size_t)32 * DIN);
  rv0 = *(const uint4*)(vptr); rv1 = *(const uint4*)(vptr + (size_t)8 * DIN);
  *(uint4*)&Ks[0][lr][lc * 8] = rk0; *(uint4*)&Ks[0][lr + 32][lc * 8] = rk1;
  *(uint4*)&Vs[0][lr][lc * 8] = rv0; *(uint4*)&Vs[0][lr + 32][lc * 8] = rv1;
  __syncthreads();
  f32x16 negm;
#pragma unroll
  for (int i = 0; i < 16; ++i) negm[i] = 0.f;
  if (!FAST) {
    f32x16 s0, s1;
#pragma unroll
    for (int i = 0; i < 16; ++i) { s0[i] = 0.f; s1[i] = 0.f; }
#pragma unroll
    for (int s = 0; s < 4; ++s) {
      bf16x8 a0 = *(const bf16x8*)&Ks[0][r][16 * s + 8 * hh];
      bf16x8 a1 = *(const bf16x8*)&Ks[0][32 + r][16 * s + 8 * hh];
      s0 = mfma32(a0, qf[s], s0);
      s1 = mfma32(a1, qf[s], s1);
    }
    float mx = fmaxf(s0[0], s1[0]);
#pragma unroll
    for (int i = 1; i < 16; ++i) mx = fmaxf(fmaxf(mx, s0[i]), s1[i]);
    mx = fmaxf(mx, __shfl_xor(mx, 32));
#pragma unroll
    for (int i = 0; i < 16; ++i) negm[i] = -mx;
  }
  float lrun = 0.f;
  f32x16 o0, o1;
#pragma unroll
  for (int i = 0; i < 16; ++i) { o0[i] = 0.f; o1[i] = 0.f; }
  const int ntile = nkeys >> 6;
  for (int t = 0; t < ntile; ++t) {
    const int cur = t & 1;
    if (t + 1 < ntile) {
      const size_t ko = (size_t)(t + 1) * 64 * DIN;
      rk0 = *(const uint4*)(kptr + ko); rk1 = *(const uint4*)(kptr + ko + (size_t)32 * DIN);
      rv0 = *(const uint4*)(vptr + ko); rv1 = *(const uint4*)(vptr + ko + (size_t)8 * DIN);
    }
    f32x16 s0, s1;
    __builtin_amdgcn_s_setprio(1);
    {
      bf16x8 a0 = *(const bf16x8*)&Ks[cur][r][8 * hh];
      bf16x8 a1 = *(const bf16x8*)&Ks[cur][32 + r][8 * hh];
      if (FAST) {
        f32x16 z;
#pragma unroll
        for (int i = 0; i < 16; ++i) z[i] = 0.f;
        s0 = mfma32(a0, qf[0], z);
        s1 = mfma32(a1, qf[0], z);
      } else {
        s0 = mfma32(a0, qf[0], negm);
        s1 = mfma32(a1, qf[0], negm);
      }
    }
#pragma unroll
    for (int s = 1; s < 4; ++s) {
      bf16x8 a0 = *(const bf16x8*)&Ks[cur][r][16 * s + 8 * hh];
      bf16x8 a1 = *(const bf16x8*)&Ks[cur][32 + r][16 * s + 8 * hh];
      s0 = mfma32(a0, qf[s], s0);
      s1 = mfma32(a1, qf[s], s1);
    }
    __builtin_amdgcn_s_setprio(0);
    float mx = 0.f;
    if (!FAST) {
      mx = fmaxf(s0[0], s1[0]);
#pragma unroll
      for (int i = 1; i < 16; ++i) mx = fmaxf(fmaxf(mx, s0[i]), s1[i]);
    }
    float rs0 = 0.f, rs1 = 0.f;
#pragma unroll
    for (int i = 0; i < 16; ++i) { s0[i] = __builtin_amdgcn_exp2f(s0[i]); rs0 += s0[i]; }
#pragma unroll
    for (int i = 0; i < 16; ++i) { s1[i] = __builtin_amdgcn_exp2f(s1[i]); rs1 += s1[i]; }
    lrun += rs0 + rs1;
    bf16x8 pb[2][2];
#pragma unroll
    for (int s = 0; s < 2; ++s) {
      unsigned u0 = pack2(s0[8 * s + 0], s0[8 * s + 1]), u1 = pack2(s0[8 * s + 2], s0[8 * s + 3]);
      unsigned u2 = pack2(s0[8 * s + 4], s0[8 * s + 5]), u3 = pack2(s0[8 * s + 6], s0[8 * s + 7]);
      uint4 uu = uint4{u0, u1, u2, u3};
      pb[0][s] = __builtin_bit_cast(bf16x8, uu);
      unsigned w0 = pack2(s1[8 * s + 0], s1[8 * s + 1]), w1 = pack2(s1[8 * s + 2], s1[8 * s + 3]);
      unsigned w2 = pack2(s1[8 * s + 4], s1[8 * s + 5]), w3 = pack2(s1[8 * s + 6], s1[8 * s + 7]);
      uint4 ww = uint4{w0, w1, w2, w3};
      pb[1][s] = __builtin_bit_cast(bf16x8, ww);
    }
#pragma unroll
    for (int kh = 0; kh < 2; ++kh)
#pragma unroll
      for (int s = 0; s < 2; ++s) {
        const int kc = 32 * kh + 16 * s + 8 * hh;
        bf16x8 va0 = *(const bf16x8*)&Vs[cur][r][kc];
        bf16x8 va1 = *(const bf16x8*)&Vs[cur][32 + r][kc];
        o0 = mfma32(va0, pb[kh][s], o0);
        o1 = mfma32(va1, pb[kh][s], o1);
      }
    if (!FAST && __builtin_amdgcn_ballot_w64(mx > 12.f) != 0ull) {
      const float mxp = fmaxf(mx, __shfl_xor(mx, 32));
      const float shift = mxp > 12.f ? mxp : 0.f;
      const float f = __builtin_amdgcn_exp2f(-shift);
      lrun *= f;
#pragma unroll
      for (int i = 0; i < 16; ++i) { o0[i] *= f; o1[i] *= f; negm[i] -= shift; }
    }
    if (t + 1 < ntile) {
      *(uint4*)&Ks[cur ^ 1][lr][lc * 8] = rk0; *(uint4*)&Ks[cur ^ 1][lr + 32][lc * 8] = rk1;
      *(uint4*)&Vs[cur ^ 1][lr][lc * 8] = rv0; *(uint4*)&Vs[cur ^ 1][lr + 32][lc * 8] = rv1;
    }
    __syncthreads();
  }
  const float ltot = lrun + __shfl_xor(lrun, 32);
  const float inv = 1.f / ltot;
#pragma unroll
  for (int dh = 0; dh < 2; ++dh)
#pragma unroll
    for (int g = 0; g < 4; ++g) {
      const int d0 = 32 * dh + 8 * g + 4 * hh;
      uint2 gau = *(const uint2*)(prow + C_GA + hq * 64 + d0);
      float v0 = (dh ? o1[4 * g + 0] : o0[4 * g + 0]) * inv * silu(bflo(gau.x));
      float v1 = (dh ? o1[4 * g + 1] : o0[4 * g + 1]) * inv * silu(bfhi(gau.x));
      float v2 = (dh ? o1[4 * g + 2] : o0[4 * g + 2]) * inv * silu(bflo(gau.y));
      float v3 = (dh ? o1[4 * g + 3] : o0[4 * g + 3]) * inv * silu(bfhi(gau.y));
      uint2 o; o.x = pack2(v0, v1); o.y = pack2(v2, v3);
      if (!dry) *(uint2*)(prow + C_Q + hq * 64 + d0) = o;
    }
}


DI void attn_item(const Params& p, int l, int b, int hq, int qt0, int nkeys, char* smem, bool dry) {
  const int lane = opaque_tid() & 63;
  float gq = fabsf(p.q_norm_g[l * 64 + lane]), gk = fabsf(p.k_norm_g[l * 64 + lane]);
#pragma unroll
  for (int off = 32; off >= 1; off >>= 1) { gq = fmaxf(gq, __shfl_xor(gq, off)); gk = fmaxf(gk, __shfl_xor(gk, off)); }
  const float bound = 64.f * 0.125f * 1.4426950408889634f * gq * gk * 1.01f;
  if (__builtin_amdgcn_readfirstlane(bound < 60.f ? 1 : 0)) attn_item_t<true>(p, b, hq, qt0, nkeys, smem, dry);
  else attn_item_t<false>(p, b, hq, qt0, nkeys, smem, dry);
}

#define XB_TMO      128
#define XB_XCNT(j)  (256  + 64 * (j))
#define XB_XSUB(j)  (1280 + 64 * (j))
#define XB_XGEN(j)  (2304 + 64 * (j))
#define XB_TOP      3328
#define XB_TOPGEN   3392
#define XCD_BAR_WORDS 3456
#define XB_SPIN_CAP (1u << 20)
#define LAS __attribute__((address_space(3)))
DI unsigned xb_ld(unsigned* p) { return __hip_atomic_load(p, __ATOMIC_RELAXED, __HIP_MEMORY_SCOPE_AGENT); }
DI unsigned xb_add(unsigned* p, unsigned v) { return __hip_atomic_fetch_add(p, v, __ATOMIC_RELAXED, __HIP_MEMORY_SCOPE_AGENT); }
DI unsigned xb_xcc_id() { return (unsigned)__builtin_amdgcn_s_getreg((3 << 11) | 20) & 0xFu; }
#define XB_SPIN(cond, bar) do { unsigned _sp = 0; while (cond) { __builtin_amdgcn_s_sleep(1); \
    if ((++_sp & 255u) == 0u) { if (xb_ld(&(bar)[XB_TMO])) break; if (_sp > XB_SPIN_CAP) { atomicAdd(&(bar)[XB_TMO], 1u); break; } } } } while (0)
struct XcdBarrier { unsigned* bar; unsigned x; volatile LAS unsigned* st; };
DI XcdBarrier xcd_barrier_post(unsigned* bar, volatile LAS unsigned* st) {
  XcdBarrier b; b.bar = bar; b.x = xb_xcc_id(); b.st = st;
  if (threadIdx.x == 0) (void)xb_add(&bar[XB_XCNT(b.x)], 1u);
  return b;
}
DI void xcd_barrier_complete(unsigned* bar, unsigned x, unsigned& nloc, unsigned& nx) {
  const unsigned G = gridDim.x * gridDim.y * gridDim.z;
  unsigned sum, cnt, mine, sp = 0u;
  for (;;) {
    sum = 0u; cnt = 0u; mine = 0u;
#pragma unroll
    for (unsigned j = 0; j < 16; ++j) { const unsigned c = xb_ld(&bar[XB_XCNT(j)]); sum += c; cnt += (c > 0u) ? 1u : 0u; mine = (j == x) ? c : mine; }
    if (sum == G) break;
    __builtin_amdgcn_s_sleep(1);
    if ((++sp & 255u) == 0u) { if (xb_ld(&bar[XB_TMO])) break; if (sp > XB_SPIN_CAP) { atomicAdd(&bar[XB_TMO], 1u); break; } }
  }
  nloc = mine > 0u ? mine : 1u; nx = cnt > 0u ? cnt : 1u;
}
DI void xcd_barrier(const XcdBarrier& b) {
  asm volatile("s_waitcnt vmcnt(0)" ::: "memory");
  __syncthreads();
  if (threadIdx.x == 0) {
    unsigned* bar = b.bar;
    __builtin_amdgcn_s_waitcnt(0);
    unsigned nloc = b.st[0], nx = b.st[1];
    if (nloc == 0u) { xcd_barrier_complete(bar, b.x, nloc, nx); b.st[0] = nloc; b.st[1] = nx; }
    const unsigned old = xb_add(&bar[XB_XSUB(b.x)], 1u);
    const unsigned gen = old / nloc;
    if (old + 1u == (gen + 1u) * nloc) {
      __builtin_amdgcn_fence(__ATOMIC_RELEASE, "agent");
      asm volatile("s_waitcnt vmcnt(0)" ::: "memory");
      const unsigned og = xb_add(&bar[XB_TOP], 1u);
      const unsigned tg = og / nx;
      if (og + 1u == (tg + 1u) * nx) xb_add(&bar[XB_TOPGEN], 1u);
      else XB_SPIN(xb_ld(&bar[XB_TOPGEN]) == tg, bar);
      __builtin_amdgcn_fence(__ATOMIC_ACQUIRE, "agent");
      xb_add(&bar[XB_XGEN(b.x)], 1u);
      asm volatile("s_waitcnt vmcnt(0)" ::: "memory");
    } else {
      XB_SPIN(xb_ld(&bar[XB_XGEN(b.x)]) == gen, bar);
      __builtin_amdgcn_fence(__ATOMIC_ACQUIRE, "agent");
      asm volatile("s_waitcnt vmcnt(0)" ::: "memory");
    }
  }
  __syncthreads();
}

DI void run_phase(const Params& p, int ph, char* smem, bool dry, int sel) {
  const int bid = blockIdx.x, nb = gridDim.x;
  if (ph == 0) {
    for (int it = bid; it < 769; it += nb) {
      if (it < 768) mod_partial_item(p, it, smem); else rope_item(p);
    }
    return;
  }
  if (ph == 1) {
    for (int it = bid; it < 240; it += nb) mod_reduce_item(p, it);
    return;
  }
  const int l = (ph - 2) / 6, k = (ph - 2) % 6;
  const bool last = (l == 3);
  if (k == 0) {
    const int n_tr = 16 * 104, n_g = 64;
    const int n_items = n_tr + n_g + MALL / 4;
    int it = bid;
    for (; it < n_tr + n_g; it += nb) {
      if (it < n_tr) {
        int rt = it & 15, ct = it >> 4;
        transpose_tile(p.w_in + (size_t)l * 1024 * DIN, 1024, DIN, p.Wt_in, HP, rt * 64, ct * 64, smem);
      } else {
        int mat = it - n_tr;
        transpose_tile(p.gate_w + (size_t)l * 262144 + (size_t)mat * 4096, 64, 64, p.Wg + (size_t)mat * 4096, 64, 0, 0, smem);
      }
    }
    norm_run(p, l, it - n_tr - n_g, nb, n_items - n_tr - n_g);
  } else if (k == 1) {
    if ((nb & 7) == 0) {
      const int xcd = bid & 7, rm = xcd >> 1, rn = xcd & 1;
      const int jstep = nb >> 3;
      int j = bid >> 3;
#define G1_ITEM(JJ, OUT) { int mi_, ni_; \
        if ((JJ) < 34 * 24) { const int ch_ = (JJ) / 272, rr_ = (JJ) % 272; mi_ = rr_ >> 3; ni_ = ch_ * 8 + (rr_ & 7); } \
        else { const int rr_ = (JJ) - 34 * 24; mi_ = rr_ >> 1; ni_ = 24 + (rr_ & 1); } \
        OUT = (34 * rm + mi_) * 52 + 26 * rn + ni_; }
      bool primed = false;
      for (; j < 34 * 26; j += jstep) {
        int item, nitem = -1;
        G1_ITEM(j, item)
        if (j + jstep < 34 * 26) G1_ITEM(j + jstep, nitem)
        g1_tile(p, item, smem, primed, nitem);
        primed = nitem >= 0;
      }
#undef G1_ITEM
    } else {
      for (int it = bid; it < 136 * 52; it += nb) g1_tile(p, it, smem);
    }
  } else if (k == 2) {
    const int n_v = MALL / 64, n_q = n_v + MALL / 32, n_l = NBATCH * NCHUNK * 16, n_t = 3 * 256;
    if ((nb & 15) == 0 && sel == 0) {
      const int it_q = bid + ((n_q - bid + nb - 1) / nb) * nb;
      const bool lru_first = bid >= (nb >> 1);
      if (lru_first) lru1_run(p, l, it_q - n_q, nb, n_l, smem);
      for (int i2 = bid; i2 < n_q; i2 += nb) {
        if (i2 < n_v) vt_item(p, i2, smem, dry); else qk_item(p, l, i2 - n_v, dry);
      }
      if (!lru_first) lru1_run(p, l, it_q - n_q, nb, n_l, smem);
      int it = it_q;
      while (it < n_q + n_l) it += nb;
      for (; it < n_q + n_l + n_t; it += nb) {
        int j = it - n_q - n_l;
        int which = j >> 8, tt = j & 255;
        const float* src = (which == 0 ? p.w_a : (which == 1 ? p.w_b : p.w_o)) + (size_t)l * 1024 * 1024;
        transpose_tile(src, 1024, 1024, p.Wt_abo + (size_t)which * 1024 * HP, HP, (tt & 15) * 64, (tt >> 4) * 64, smem);
      }
    } else {
    for (int it = bid; it < n_q + n_l + n_t; it += nb) {
      if (sel == 1 && !(it >= n_q && it < n_q + n_l)) continue;
      if (sel == 2 && (it >= n_q && it < n_q + n_l)) continue;
      if (it < n_v) {
        vt_item(p, it, smem, dry);
      } else if (it < n_q) {
        qk_item(p, l, it - n_v, dry);
      } else if (it < n_q + n_l) {
        int j = it - n_q;
        int blk = j & 15, rest = j >> 4;
        lru_item(p, l, rest / NCHUNK, rest % NCHUNK, blk, 1, smem, dry);
      } else {
        int j = it - n_q - n_l;
        int which = j >> 8, tt = j & 255;
        const float* src = (which == 0 ? p.w_a : (which == 1 ? p.w_b : p.w_o)) + (size_t)l * 1024 * 1024;
        transpose_tile(src, 1024, 1024, p.Wt_abo + (size_t)which * 1024 * HP, HP, (tt & 15) * 64, (tt >> 4) * 64, smem);
      }
    }
    }
  } else if (k == 3) {
    const int n_al = 2048, n_ac = last ? 0 : 128, n_l = NBATCH * NCHUNK * 16;
    const bool lru_first = bid >= (nb >> 1);
    for (int stage = 0; stage < 2; ++stage) {
      const bool do_lru = (stage == 0) == lru_first;
      if (do_lru) {
        if (sel == 2) continue;
        for (int j = bid; j < (n_l >> 2); j += nb) lru2_wave(p, j * 4 + (opaque_tid() >> 6), last, dry);
      } else {
        if (sel == 1) continue;
        for (int it = bid; it < n_al + n_ac; it += nb) {
          if (it < n_al) {
            int x = it & 7, j = it >> 3;
            int pair = 2 * x + (j >> 7);
            int idx = j & 127;
            int b = pair >> 2, kvh = pair & 3, g = idx & 3, qb = idx >> 2;
            attn_item(p, l, b, kvh * 4 + g, CTXL + qb * 128, TOK, smem, dry);
          } else {
            int j = it - n_al;
            int qb = j & 1, hq = (j >> 1) & 15, b = j >> 5;
            attn_item(p, l, b, hq, qb * 128, CTXL, smem, dry);
          }
        }
      }
    }
  } else {
    const int n_mt = last ? 128 : 136;
    if ((nb & 7) == 0) {
      const int xcd = bid & 7, mpx = n_mt >> 3;
      const int jstep = nb >> 3;
      bool primed = false;
      for (int j = bid >> 3; j < mpx * 8; j += jstep) {
        const int mi = xcd * mpx + (j >> 3), nt = j & 7;
        const int mt = last ? ((mi >> 5) * 34 + 2 + (mi & 31)) : mi;
        int nmt = -1, nnt = 0;
        if (j + jstep < mpx * 8) {
          const int mi2 = xcd * mpx + ((j + jstep) >> 3);
          nnt = (j + jstep) & 7;
          nmt = last ? ((mi2 >> 5) * 34 + 2 + (mi2 & 31)) : mi2;
        }
        if (k == 4) g2_tile(p, mt, nt, smem, dry, primed, nmt, nnt); else g3_tile(p, l, mt, nt, smem, dry, primed, nmt, nnt);
        primed = nmt >= 0;
      }
    } else {
      for (int it = bid; it < n_mt * 8; it += nb) {
        int mi = it >> 3, nt = it & 7;
        int mt = last ? ((mi >> 5) * 34 + 2 + (mi & 31)) : mi;
        if (k == 4) g2_tile(p, mt, nt, smem, dry); else g3_tile(p, l, mt, nt, smem, dry);
      }
    }
  }
}

__global__ void __launch_bounds__(256, 2) mega(Params p, int ph_begin, int ph_end, int coop, int dupmask) {
  extern __shared__ __attribute__((aligned(16))) char smem[];
  __shared__ uint4 xb_words;
  XcdBarrier xb;
  xb.bar = p.bar; xb.x = 0u; xb.st = (volatile LAS unsigned*)&xb_words;
  if (coop) {
    if (threadIdx.x == 0) xb_words = make_uint4(0u, 0u, 0u, 0u);
    __syncthreads();
    xb = xcd_barrier_post(p.bar, (volatile LAS unsigned*)&xb_words);
  }
  for (int ph = ph_begin; ph < ph_end; ++ph) {
    if (DUPMASK != 0 && dupmask) {
      const int kk = ph >= 2 ? (ph - 2) % 6 : 7;
      if ((dupmask >> kk) & 1) { run_phase(p, ph, smem, (dupmask & 0x100) != 0, (dupmask >> 9) & 3); if (coop == 1) xcd_barrier(xb); }
    }
    run_phase(p, ph, smem, false, 0);
    if (ph + 1 < ph_end) {
      if (coop == 1) xcd_barrier(xb);
      else if (coop == 2) cg::this_grid().sync();
    }
  }
}

extern "C" void kernel_launch(void* const* d_in, const int* in_sizes, int n_in, void* d_out, int out_size, void* d_ws,
                              size_t ws_size, hipStream_t stream) {
  Params p{};
  p.x = (const float*)d_in[0]; p.c = (const float*)d_in[1]; p.ctx = (const float*)d_in[2]; p.c_ctx = (const float*)d_in[3];
  p.norm_g = (const float*)d_in[4]; p.w_mod = (const float*)d_in[5]; p.b_mod = (const float*)d_in[6]; p.w_in = (const float*)d_in[7];
  p.q_norm_g = (const float*)d_in[8]; p.k_norm_g = (const float*)d_in[9]; p.conv_w = (const float*)d_in[10];
  p.conv_b = (const float*)d_in[11]; p.gate_w = (const float*)d_in[12]; p.gate_b = (const float*)d_in[13];
  p.lam = (const float*)d_in[14]; p.w_a = (const float*)d_in[15]; p.w_b = (const float*)d_in[16]; p.w_o = (const float*)d_in[17];
  p.out = (float*)d_out;
  char* ws = (char*)d_ws;
  size_t off = 0;
  p.P = (bf16_t*)(ws + off); off += (size_t)MALL * DIN * 2;
  p.Hs = (bf16_t*)(ws + off); p.agg = (float*)(ws + off); off += (size_t)MALL * HP * 2;
  p.Wt_in = (bf16_t*)(ws + off); p.Wt_abo = (bf16_t*)(ws + off); off += (size_t)DIN * HP * 2;
  p.Xctx = (float*)(ws + off); off += (size_t)NBATCH * CTXL * DM * 4;
  p.mod = (float*)(ws + off); off += (size_t)4 * 5 * 3072 * 4;
  p.rope = (float*)(ws + off); off += (size_t)64 * 16 * 2 * 4;
  p.bar = (unsigned*)(ws + off); off += (size_t)XCD_BAR_WORDS * 4;
  p.Wg = (bf16_t*)(ws + off); off += (size_t)262144 * 2;
  p.modp = (float*)(ws + off); off += (size_t)16 * 61440 * 4;
  p.lab = (bf16_t*)(ws + off); off += (size_t)NBATCH * NCHUNK * 16 * 32768;
  if (off > ws_size) { fprintf(stderr, "workspace too small: need %zu have %zu\n", off, ws_size); return; }

  static int grid_blocks = 0;
  if (!grid_blocks) {
    int dev = 0, cus = 0, per_cu = 0;
    hipGetDevice(&dev);
    hipDeviceGetAttribute(&cus, hipDeviceAttributeMultiprocessorCount, dev);
    hipFuncSetAttribute((const void*)mega, hipFuncAttributeMaxDynamicSharedMemorySize, SMEM_BYTES);
    hipOccupancyMaxActiveBlocksPerMultiprocessor(&per_cu, mega, 256, SMEM_BYTES);
    if (per_cu < 1) per_cu = 1;
    if (per_cu > 2) per_cu = 2;
    grid_blocks = cus * per_cu;
  }
#if MULTI
  for (int ph = 0; ph < NPH; ++ph) {
    hipLaunchKernelGGL(mega, dim3(grid_blocks), dim3(256), SMEM_BYTES, stream, p, ph, ph + 1, 0, 0);
  }
#else
  hipMemsetAsync(p.bar, 0, (size_t)XCD_BAR_WORDS * 4, stream);
  int b0 = 0, e0 = NPH, coop = 1, dupmask = DUPMASK;
  void* args[] = {&p, &b0, &e0, &coop, &dupmask};
  hipError_t e = hipLaunchCooperativeKernel((const void*)mega, dim3(grid_blocks), dim3(256), args, SMEM_BYTES, stream);
  if (e != hipSuccess) fprintf(stderr, "cooperative launch failed: %s (grid %d)\n", hipGetErrorString(e), grid_blocks);
#endif
}
```

```cpp
#include <hip/hip_runtime.h>
#include <hip/hip_cooperative_groups.h>
#include <stdint.h>
#include <stdio.h>
namespace cg = cooperative_groups;

#ifndef MULTI
#define MULTI 0
#endif

#ifndef DUPMASK
#define DUPMASK 0
#endif
#define DI __device__ __forceinline__
typedef unsigned short bf16_t;
typedef __attribute__((ext_vector_type(8))) short bf16x8;
typedef __attribute__((ext_vector_type(4))) short s16x4;
typedef __attribute__((ext_vector_type(4))) float f32x4;
typedef __attribute__((ext_vector_type(16))) float f32x16;

constexpr int DM = 1024;
constexpr int NBATCH = 4;
constexpr int SEQ = 4096;
constexpr int CTXL = 256;
constexpr int TOK = SEQ + CTXL;
constexpr int MALL = NBATCH * TOK;
constexpr int MHALF = MALL / 2;
constexpr int DIN = 6656;
constexpr int HP = 1024;
constexpr int C_Q = 0, C_K = 1024, C_V = 1280, C_GA = 1536, C_U = 2560, C_GB = 3584, C_GM = 4608;
constexpr int NCHUNK = TOK / 64;
constexpr int SMEM_BYTES = 73728;
constexpr int NPH = 2 + 6 * 4;

struct Params {
  const float* x; const float* c; const float* ctx; const float* c_ctx; const float* norm_g; const float* w_mod;
  const float* b_mod; const float* w_in; const float* q_norm_g; const float* k_norm_g; const float* conv_w;
  const float* conv_b; const float* gate_w; const float* gate_b; const float* lam; const float* w_a; const float* w_b;
  const float* w_o;
  float* out;
  bf16_t* P;
  bf16_t* Hs;
  float* agg;
  bf16_t* Wt_in;
  bf16_t* Wt_abo;
  float* Xctx;
  float* mod;
  float* rope;
  bf16_t* Wg;
  float* modp;
  bf16_t* lab;
  unsigned* bar;
};

typedef float f32x2_t __attribute__((ext_vector_type(2)));
typedef __bf16 bf16x2_t __attribute__((ext_vector_type(2)));
DI unsigned pack2(float a, float b) { f32x2_t v = {a, b}; bf16x2_t r = __builtin_convertvector(v, bf16x2_t); return __builtin_bit_cast(unsigned, r); }
DI unsigned f2bf(float x) { return pack2(x, 0.f) & 0xffffu; }
DI float bflo(unsigned u) { return __uint_as_float(u << 16); }
DI float bfhi(unsigned u) { return __uint_as_float(u & 0xffff0000u); }
DI float bf2f(bf16_t b) { return __uint_as_float(((unsigned)b) << 16); }
DI float sigm(float x) { return __builtin_amdgcn_rcpf(1.f + __builtin_amdgcn_exp2f(-1.4426950408889634f * x)); }
DI float silu(float x) { return x * sigm(x); }
DI f32x4 mfma16(bf16x8 a, bf16x8 b, f32x4 c) { return __builtin_amdgcn_mfma_f32_16x16x32_bf16(a, b, c, 0, 0, 0); }
DI f32x16 mfma32(bf16x8 a, bf16x8 b, f32x16 c) { return __builtin_amdgcn_mfma_f32_32x32x16_bf16(a, b, c, 0, 0, 0); }

DI int opaque_tid() { int t = threadIdx.x; asm volatile("" : "+v"(t)); return t; }

DI const float* xrow(const Params& p, int l, int b, int t) {
  if (t < CTXL) return (l == 0 ? p.ctx : (const float*)p.Xctx) + (size_t)(b * CTXL + t) * DM;
  return (l == 0 ? p.x : (const float*)p.out) + (size_t)(b * SEQ + (t - CTXL)) * DM;
}

DI void mod_partial_item(const Params& p, int item, char* smem) {
  float* sc = (float*)smem;
  float* red = sc + 320;
  const int l = item / 192, rem = item % 192, cc = rem >> 4, kc = rem & 15;
  const int tid = opaque_tid(), w = tid >> 6, lane = tid & 63;
  for (int i = tid; i < 320; i += 256) {
    const int s = i >> 6, k = kc * 64 + (i & 63);
    const float v = (s < 4) ? p.c[s * 1024 + k] : p.c_ctx[k];
    sc[i] = silu(v);
  }
  __syncthreads();
  const float* wp = p.w_mod + ((size_t)l * 1024 + kc * 64 + w * 16) * 3072 + cc * 256 + lane * 4;
  float4 wv[16];
#pragma unroll
  for (int i = 0; i < 16; ++i) wv[i] = *(const float4*)(wp + (size_t)i * 3072);
  float4 acc[5];
#pragma unroll
  for (int s = 0; s < 5; ++s) acc[s] = float4{0.f, 0.f, 0.f, 0.f};
#pragma unroll
  for (int i = 0; i < 16; ++i) {
#pragma unroll
    for (int s = 0; s < 5; ++s) {
      const float cv = sc[s * 64 + w * 16 + i];
      acc[s].x += cv * wv[i].x; acc[s].y += cv * wv[i].y; acc[s].z += cv * wv[i].z; acc[s].w += cv * wv[i].w;
    }
  }
#pragma unroll
  for (int s = 0; s < 5; ++s) *(float4*)(red + (w * 5 + s) * 256 + lane * 4) = acc[s];
  __syncthreads();
  {
    const int col = tid;
#pragma unroll
    for (int s = 0; s < 5; ++s) {
      const float v = red[(0 * 5 + s) * 256 + col] + red[(1 * 5 + s) * 256 + col] + red[(2 * 5 + s) * 256 + col] + red[(3 * 5 + s) * 256 + col];
      p.modp[(size_t)kc * 61440 + (size_t)(l * 5 + s) * 3072 + cc * 256 + col] = v;
    }
  }
  __syncthreads();
}

DI void mod_reduce_item(const Params& p, int item) {
  const int idx = item * 256 + opaque_tid();
  const int n = idx % 3072, l = idx / (5 * 3072);
  float v = p.b_mod[l * 3072 + n];
#pragma unroll
  for (int kc = 0; kc < 16; ++kc) v += p.modp[(size_t)kc * 61440 + idx];
  p.mod[idx] = v;
}

DI void rope_item(const Params& p) {
  for (int idx = opaque_tid(); idx < 1024; idx += 256) {
    int pos = idx >> 4, i = idx & 15;
    float freq = exp2f(-(float)i * (13.287712379549449f / 16.f));
    float ang = (float)pos * freq;
    float rev = ang * 0.15915494309189535f;
    rev -= floorf(rev);
    p.rope[idx * 2 + 0] = __builtin_amdgcn_cosf(rev);
    p.rope[idx * 2 + 1] = __builtin_amdgcn_sinf(rev);
  }
}

DI void transpose_tile(const float* __restrict__ src, int R, int C, bf16_t* __restrict__ dst, int dp, int r0, int c0, char* smem) {
  float (*tl)[65] = (float (*)[65])smem;
  const int tid = opaque_tid();
#pragma unroll
  for (int i = 0; i < 4; ++i) {
    int r = (tid >> 4) + 16 * i, c = (tid & 15) * 4;
    float4 v = *(const float4*)(src + (size_t)(r0 + r) * C + c0 + c);
    tl[r][c] = v.x; tl[r][c + 1] = v.y; tl[r][c + 2] = v.z; tl[r][c + 3] = v.w;
  }
  __syncthreads();
#pragma unroll
  for (int i = 0; i < 2; ++i) {
    int n = (tid >> 3) + 32 * i, k8 = (tid & 7) * 8;
    uint4 o;
    o.x = pack2(tl[k8][n], tl[k8 + 1][n]); o.y = pack2(tl[k8 + 2][n], tl[k8 + 3][n]);
    o.z = pack2(tl[k8 + 4][n], tl[k8 + 5][n]); o.w = pack2(tl[k8 + 6][n], tl[k8 + 7][n]);
    *(uint4*)(dst + (size_t)(c0 + n) * dp + r0 + k8) = o;
  }
  __syncthreads();
}

DI void norm_item(const Params& p, int l, int item) {
  const int tid = opaque_tid(); const int w = tid >> 6, lane = tid & 63;
  const int m = item * 4 + w;
  const int b = m / TOK, t = m % TOK;
  const float* src = xrow(p, l, b, t);
  const int s = (t < CTXL) ? 4 : b;
  const float* md = p.mod + (size_t)(l * 5 + s) * 3072;
  const float* g = p.norm_g + l * 1024;
  float4 v[4];
  float ss = 0.f;
#pragma unroll
  for (int i = 0; i < 4; ++i) {
    v[i] = *(const float4*)(src + (i * 64 + lane) * 4);
    ss += v[i].x * v[i].x + v[i].y * v[i].y + v[i].z * v[i].z + v[i].w * v[i].w;
  }
#pragma unroll
  for (int off = 32; off >= 1; off >>= 1) ss += __shfl_xor(ss, off);
  const float rstd = rsqrtf(ss * (1.f / 1024.f) + 1e-6f);
  bf16_t* dst = p.Hs + (size_t)m * HP;
#pragma unroll
  for (int i = 0; i < 4; ++i) {
    int k = (i * 64 + lane) * 4;
    float4 gg = *(const float4*)(g + k), sh = *(const float4*)(md + k), scl = *(const float4*)(md + 1024 + k);
    float h0 = v[i].x * rstd * gg.x * (1.f + scl.x) + sh.x;
    float h1 = v[i].y * rstd * gg.y * (1.f + scl.y) + sh.y;
    float h2 = v[i].z * rstd * gg.z * (1.f + scl.z) + sh.z;
    float h3 = v[i].w * rstd * gg.w * (1.f + scl.w) + sh.w;
    uint2 o; o.x = pack2(h0, h1); o.y = pack2(h2, h3);
    *(uint2*)(dst + k) = o;
  }
}

DI void norm_run(const Params& p, int l, int i0, int nb, int n_items) {
  if (i0 >= n_items) return;
  const int tid = opaque_tid(); const int w = tid >> 6, lane = tid & 63;
  const float* g = p.norm_g + l * 1024;
  float4 gg[4];
#pragma unroll
  for (int i = 0; i < 4; ++i) gg[i] = *(const float4*)(g + (i * 64 + lane) * 4);
  float4 v[4], vn[4];
  {
    const int m = i0 * 4 + w;
    const float* src = xrow(p, l, m / TOK, m % TOK);
#pragma unroll
    for (int i = 0; i < 4; ++i) v[i] = *(const float4*)(src + (i * 64 + lane) * 4);
  }
  for (int it = i0; it < n_items; it += nb) {
    const int m = it * 4 + w;
    const int b = m / TOK, t = m % TOK;
    const bool more = it + nb < n_items;
    if (more) {
      const int m2 = (it + nb) * 4 + w;
      const float* src2 = xrow(p, l, m2 / TOK, m2 % TOK);
#pragma unroll
      for (int i = 0; i < 4; ++i) vn[i] = *(const float4*)(src2 + (i * 64 + lane) * 4);
    }
    const float* md = p.mod + (size_t)(l * 5 + ((t < CTXL) ? 4 : b)) * 3072;
    float ss = 0.f;
#pragma unroll
    for (int i = 0; i < 4; ++i) ss += v[i].x * v[i].x + v[i].y * v[i].y + v[i].z * v[i].z + v[i].w * v[i].w;
#pragma unroll
    for (int off = 32; off >= 1; off >>= 1) ss += __shfl_xor(ss, off);
    const float rstd = rsqrtf(ss * (1.f / 1024.f) + 1e-6f);
    bf16_t* dst = p.Hs + (size_t)m * HP;
#pragma unroll
    for (int i = 0; i < 4; ++i) {
      const int k = (i * 64 + lane) * 4;
      const float4 sh = *(const float4*)(md + k), scl = *(const float4*)(md + 1024 + k);
      const float h0 = v[i].x * rstd * gg[i].x * (1.f + scl.x) + sh.x;
      const float h1 = v[i].y * rstd * gg[i].y * (1.f + scl.y) + sh.y;
      const float h2 = v[i].z * rstd * gg[i].z * (1.f + scl.z) + sh.z;
      const float h3 = v[i].w * rstd * gg[i].w * (1.f + scl.w) + sh.w;
      uint2 o; o.x = pack2(h0, h1); o.y = pack2(h2, h3);
      *(uint2*)(dst + k) = o;
    }
    if (more) {
#pragma unroll
      for (int i = 0; i < 4; ++i) v[i] = vn[i];
    }
  }
}

template <int KK0, int KK1>
DI void gemm_compute(const bf16_t (*As)[128][64], const bf16_t (*Bs)[128][64], int cur, int wm, int wn, int fr, int fq,
                     f32x4 (&acc)[4][4]) {
  const int sw = (fr >> 1) & 7;
#pragma unroll
  for (int kk = KK0; kk < KK1; ++kk) {
    bf16x8 af[4], bfr[4];
#pragma unroll
    for (int i = 0; i < 4; ++i) af[i] = *(const bf16x8*)&As[cur][64 * wm + 16 * i + fr][((4 * kk + fq) ^ sw) * 8];
#pragma unroll
    for (int j = 0; j < 4; ++j) bfr[j] = *(const bf16x8*)&Bs[cur][64 * wn + 16 * j + fr][((4 * kk + fq) ^ sw) * 8];
#pragma unroll
    for (int i = 0; i < 4; ++i)
#pragma unroll
      for (int j = 0; j < 4; ++j) acc[i][j] = mfma16(bfr[j], af[i], acc[i][j]);
  }
}

DI void gemm_mainloop(const bf16_t* __restrict__ A, int lda, const bf16_t* __restrict__ Bt, int ldb, int m0, int n0, int K,
                      f32x4 (&acc)[4][4], char* smem, bool primed = false, const bf16_t* nA = nullptr, int nm0 = 0,
                      const bf16_t* nB = nullptr, int nn0 = 0) {
  typedef bf16_t (*tile_t)[128][64];
  tile_t As = (tile_t)smem;
  tile_t Bs = (tile_t)(smem + 2 * 128 * 64 * 2);
  const int tid = opaque_tid(), w = tid >> 6, lane = tid & 63, wm = w >> 1, wn = w & 1;
  const int fr = lane & 15, fq = lane >> 4;
  const int lrow = lane >> 3;
  const int ce = ((lane & 7) ^ (lane >> 4)) * 8;
  const int co = ((lane & 7) ^ (4 + (lane >> 4))) * 8;
  const bf16_t* ap0 = A + (size_t)(m0 + 32 * w + lrow) * lda;
  const bf16_t* bp0 = Bt + (size_t)(n0 + 32 * w + lrow) * ldb;
  const bf16_t* ap[4] = {ap0 + ce, ap0 + (size_t)8 * lda + co, ap0 + (size_t)16 * lda + ce, ap0 + (size_t)24 * lda + co};
  const bf16_t* bp[4] = {bp0 + ce, bp0 + (size_t)8 * ldb + co, bp0 + (size_t)16 * ldb + ce, bp0 + (size_t)24 * ldb + co};
#define GLDS1(BUF, KT, I) \
  __builtin_amdgcn_global_load_lds((const unsigned*)(ap[I] + (KT) * 64), (unsigned*)&As[BUF][32 * w + 8 * (I)][0], 16, 0, 0); \
  __builtin_amdgcn_global_load_lds((const unsigned*)(bp[I] + (KT) * 64), (unsigned*)&Bs[BUF][32 * w + 8 * (I)][0], 16, 0, 0);
#define GLDS(BUF, KT) { GLDS1(BUF, KT, 0) GLDS1(BUF, KT, 1) GLDS1(BUF, KT, 2) GLDS1(BUF, KT, 3) }
  const int nt = K >> 6;
  if (!primed) {
    GLDS(0, 0)
    GLDS(1, 1)
  }
  const bool hasnext = nA != nullptr;
  const int sw = (fr >> 1) & 7;
#define NGLDS(BUF) { \
    const bf16_t* na0 = nA + (size_t)(nm0 + 32 * w + lrow) * lda + (BUF) * 64; \
    const bf16_t* nb0 = nB + (size_t)(nn0 + 32 * w + lrow) * ldb + (BUF) * 64; \
    __builtin_amdgcn_global_load_lds((const unsigned*)(na0 + ce), (unsigned*)&As[BUF][32 * w + 0][0], 16, 0, 0); \
    __builtin_amdgcn_global_load_lds((const unsigned*)(nb0 + ce), (unsigned*)&Bs[BUF][32 * w + 0][0], 16, 0, 0); \
    __builtin_amdgcn_global_load_lds((const unsigned*)(na0 + (size_t)8 * lda + co), (unsigned*)&As[BUF][32 * w + 8][0], 16, 0, 0); \
    __builtin_amdgcn_global_load_lds((const unsigned*)(nb0 + (size_t)8 * ldb + co), (unsigned*)&Bs[BUF][32 * w + 8][0], 16, 0, 0); \
    __builtin_amdgcn_global_load_lds((const unsigned*)(na0 + (size_t)16 * lda + ce), (unsigned*)&As[BUF][32 * w + 16][0], 16, 0, 0); \
    __builtin_amdgcn_global_load_lds((const unsigned*)(nb0 + (size_t)16 * ldb + ce), (unsigned*)&Bs[BUF][32 * w + 16][0], 16, 0, 0); \
    __builtin_amdgcn_global_load_lds((const unsigned*)(na0 + (size_t)24 * lda + co), (unsigned*)&As[BUF][32 * w + 24][0], 16, 0, 0); \
    __builtin_amdgcn_global_load_lds((const unsigned*)(nb0 + (size_t)24 * ldb + co), (unsigned*)&Bs[BUF][32 * w + 24][0], 16, 0, 0); }
#define GTILE(BUF, KT2, MORE)                                                                                         \
  {                                                                                                                   \
    bf16x8 a0[4], b0[4], a1[4], b1[4];                                                                                \
    const int pc0 = ((0 + fq) ^ sw) * 8, pc1 = ((4 + fq) ^ sw) * 8;                                                   \
    _Pragma("unroll") for (int i = 0; i < 4; ++i) a0[i] = *(const bf16x8*)&As[BUF][64 * wm + 16 * i + fr][pc0];       \
    _Pragma("unroll") for (int j = 0; j < 4; ++j) b0[j] = *(const bf16x8*)&Bs[BUF][64 * wn + 16 * j + fr][pc0];       \
    _Pragma("unroll") for (int i = 0; i < 4; ++i) a1[i] = *(const bf16x8*)&As[BUF][64 * wm + 16 * i + fr][pc1];       \
    _Pragma("unroll") for (int j = 0; j < 4; ++j) b1[j] = *(const bf16x8*)&Bs[BUF][64 * wn + 16 * j + fr][pc1];       \
    asm volatile("s_waitcnt lgkmcnt(0)" ::: "memory");                                                                \
    __builtin_amdgcn_s_barrier();                              \
    if (MORE) GLDS(BUF, KT2) else if (hasnext) NGLDS(BUF)                                                             \
    _Pragma("unroll") for (int i = 0; i < 4; ++i)                                                                     \
      _Pragma("unroll") for (int j = 0; j < 4; ++j) acc[i][j] = mfma16(b0[j], a0[i], acc[i][j]);                      \
    _Pragma("unroll") for (int i = 0; i < 4; ++i)                                                                     \
      _Pragma("unroll") for (int j = 0; j < 4; ++j) acc[i][j] = mfma16(b1[j], a1[i], acc[i][j]);                      \
  }
  for (int t = 0; t < nt; t += 2) {
    const bool more = t + 2 < nt;
    asm volatile("s_waitcnt vmcnt(8)" ::: "memory");
    __builtin_amdgcn_s_barrier();
    GTILE(0, t + 2, more)
    if (more || hasnext) asm volatile("s_waitcnt vmcnt(8)" ::: "memory"); else asm volatile("s_waitcnt vmcnt(0)" ::: "memory");
    __builtin_amdgcn_s_barrier();
    GTILE(1, t + 3, more)
  }
#undef GTILE
#undef NGLDS
#undef GLDS
#undef GLDS1
}

DI void zero_acc(f32x4 (&acc)[4][4]) {
#pragma unroll
  for (int i = 0; i < 4; ++i)
#pragma unroll
    for (int j = 0; j < 4; ++j) acc[i][j] = f32x4{0.f, 0.f, 0.f, 0.f};
}

DI void g1_tile(const Params& p, int item, char* smem, bool primed = false, int next_item = -1) {
  const int mt = item / 52, nt = item % 52;
  const bf16_t* A = p.Hs;
  f32x4 acc[4][4];
  zero_acc(acc);
  if (next_item >= 0)
    gemm_mainloop(A, HP, p.Wt_in, HP, mt * 128, nt * 128, 1024, acc, smem, primed, A, (next_item / 52) * 128, p.Wt_in, (next_item % 52) * 128);
  else
    gemm_mainloop(A, HP, p.Wt_in, HP, mt * 128, nt * 128, 1024, acc, smem, primed);
  const int tid = opaque_tid(), w = tid >> 6, lane = tid & 63, wm = w >> 1, wn = w & 1;
  const int mbase = mt * 128 + 64 * wm + (lane & 15);
  const int nbase = nt * 128 + 64 * wn + 4 * (lane >> 4);
#pragma unroll
  for (int i = 0; i < 4; ++i)
#pragma unroll
    for (int j = 0; j < 4; ++j) {
      uint2 o; o.x = pack2(acc[i][j][0], acc[i][j][1]); o.y = pack2(acc[i][j][2], acc[i][j][3]);
      *(uint2*)(p.P + (size_t)(mbase + 16 * i) * DIN + nbase + 16 * j) = o;
    }
}

DI void g2_tile(const Params& p, int mt, int nt, char* smem, bool dry, bool primed = false, int nmt = -1, int nnt = 0) {
  f32x4 acc[4][4];
  const int tid = opaque_tid(), w = tid >> 6, lane = tid & 63, wm = w >> 1, wn = w & 1;
  const int mbase = mt * 128 + 64 * wm + (lane & 15);
  const int nbase = nt * 128 + 64 * wn + 4 * (lane >> 4);
  zero_acc(acc);
  gemm_mainloop(p.P + C_Q, DIN, p.Wt_abo, HP, mt * 128, nt * 128, 1024, acc, smem, primed, p.P + C_GB, mt * 128, p.Wt_abo + 1024 * HP, nt * 128);
#pragma unroll
  for (int i = 0; i < 4; ++i)
#pragma unroll
    for (int j = 0; j < 4; ++j) {
      bf16_t* pr = p.P + (size_t)(mbase + 16 * i) * DIN + C_GM + nbase + 16 * j;
      uint2 g = *(const uint2*)pr;
      uint2 o;
      o.x = pack2(acc[i][j][0] * sigm(bflo(g.x)), acc[i][j][1] * sigm(bfhi(g.x)));
      o.y = pack2(acc[i][j][2] * sigm(bflo(g.y)), acc[i][j][3] * sigm(bfhi(g.y)));
      if (!dry) *(uint2*)pr = o;
    }
  zero_acc(acc);
  if (nmt >= 0)
    gemm_mainloop(p.P + C_GB, DIN, p.Wt_abo + 1024 * HP, HP, mt * 128, nt * 128, 1024, acc, smem, true, p.P + C_Q, nmt * 128, p.Wt_abo, nnt * 128);
  else
    gemm_mainloop(p.P + C_GB, DIN, p.Wt_abo + 1024 * HP, HP, mt * 128, nt * 128, 1024, acc, smem, true);
#pragma unroll
  for (int i = 0; i < 4; ++i)
#pragma unroll
    for (int j = 0; j < 4; ++j) {
      bf16_t* pr = p.P + (size_t)(mbase + 16 * i) * DIN + C_GM + nbase + 16 * j;
      uint2 g = *(const uint2*)(pr + 1024);
      uint2 zp = *(const uint2*)pr;
      float z0 = bflo(zp.x) + acc[i][j][0] * sigm(bflo(g.x)), z1 = bfhi(zp.x) + acc[i][j][1] * sigm(bfhi(g.x));
      float z2 = bflo(zp.y) + acc[i][j][2] * sigm(bflo(g.y)), z3 = bfhi(zp.y) + acc[i][j][3] * sigm(bfhi(g.y));
      uint2 o; o.x = pack2(z0, z1); o.y = pack2(z2, z3);
      if (!dry) *(uint2*)pr = o;
    }
}

DI void g3_tile(const Params& p, int l, int mt, int nt, char* smem, bool dry, bool primed = false, int nmt = -1, int nnt = 0) {
  f32x4 acc[4][4];
  zero_acc(acc);
  if (nmt >= 0)
    gemm_mainloop(p.P + C_GM, DIN, p.Wt_abo + 2 * 1024 * HP, HP, mt * 128, nt * 128, 1024, acc, smem, primed, p.P + C_GM, nmt * 128, p.Wt_abo + 2 * 1024 * HP, nnt * 128);
  else
    gemm_mainloop(p.P + C_GM, DIN, p.Wt_abo + 2 * 1024 * HP, HP, mt * 128, nt * 128, 1024, acc, smem, primed);
  const int tid = opaque_tid(), w = tid >> 6, lane = tid & 63, wm = w >> 1, wn = w & 1;
  const int mbase = mt * 128 + 64 * wm + (lane & 15);
  const int nbase = nt * 128 + 64 * wn + 4 * (lane >> 4);
  const int b = (mt * 128) / TOK;
  const int tt0 = (mt * 128) % TOK;
  const int s = (tt0 < CTXL) ? 4 : b;
  const float* gt = p.mod + (size_t)(l * 5 + s) * 3072 + 2048;
#pragma unroll
  for (int i = 0; i < 4; ++i) {
    const int m = mbase + 16 * i;
    const int t = m - b * TOK;
    const float* xs = xrow(p, l, b, t);
    float* xd = (t < CTXL) ? (p.Xctx + (size_t)(b * CTXL + t) * DM) : (p.out + (size_t)(b * SEQ + (t - CTXL)) * DM);
#pragma unroll
    for (int j = 0; j < 4; ++j) {
      const int n = nbase + 16 * j;
      float4 xv = *(const float4*)(xs + n);
      float4 gv = *(const float4*)(gt + n);
      float4 o;
      o.x = xv.x + gv.x * acc[i][j][0]; o.y = xv.y + gv.y * acc[i][j][1];
      o.z = xv.z + gv.z * acc[i][j][2]; o.w = xv.w + gv.w * acc[i][j][3];
      if (!dry) *(float4*)(xd + n) = o;
    }
  }
}

DI void qk_finish(const uint2 (&u)[4], bf16_t* base, const float* g, const float* rope, bool lat, int rowp, int colp, int j4,
                  float sc, bool dry) {
  float v[4][4];
  float ss = 0.f;
#pragma unroll
  for (int qq = 0; qq < 4; ++qq) {
    v[qq][0] = bflo(u[qq].x); v[qq][1] = bfhi(u[qq].x); v[qq][2] = bflo(u[qq].y); v[qq][3] = bfhi(u[qq].y);
    ss += v[qq][0] * v[qq][0] + v[qq][1] * v[qq][1] + v[qq][2] * v[qq][2] + v[qq][3] * v[qq][3];
  }
  ss += __shfl_xor(ss, 1);
  ss += __shfl_xor(ss, 2);
  const float rstd = rsqrtf(ss * (1.f / 64.f) + 1e-6f);
#pragma unroll
  for (int qq = 0; qq < 4; ++qq)
#pragma unroll
    for (int e = 0; e < 4; ++e) v[qq][e] = v[qq][e] * rstd * g[16 * qq + e];
  if (lat) {
#pragma unroll
    for (int e = 0; e < 4; ++e) {
      const int fi = 4 * j4 + e;
      float2 cr = *(const float2*)(rope + (rowp * 16 + fi) * 2);
      float2 cc = *(const float2*)(rope + (colp * 16 + fi) * 2);
      float a0 = v[0][e], a1 = v[1][e], a2 = v[2][e], a3 = v[3][e];
      v[0][e] = a0 * cr.x - a1 * cr.y; v[1][e] = a1 * cr.x + a0 * cr.y;
      v[2][e] = a2 * cc.x - a3 * cc.y; v[3][e] = a3 * cc.x + a2 * cc.y;
    }
  }
#pragma unroll
  for (int qq = 0; qq < 4; ++qq) {
    uint2 o; o.x = pack2(v[qq][0] * sc, v[qq][1] * sc); o.y = pack2(v[qq][2] * sc, v[qq][3] * sc);
    if (!dry) *(uint2*)(base + 16 * qq) = o;
  }
}

DI void qk_item(const Params& p, int l, int tile, bool dry) {
  const int tid = opaque_tid(), w = tid >> 6, lane = tid & 63;
  const int m0 = tile * 32;
  const int t0 = m0 % TOK;
  const int hd = lane >> 2, j4 = lane & 3;
  const float* gq = p.q_norm_g + l * 64 + 4 * j4;
  const float* gk = p.k_norm_g + l * 64 + 4 * j4;
  for (int tt = 0; tt < 8; tt += 2) {
    uint2 uq[2][4], uk[2][4];
#pragma unroll
    for (int x = 0; x < 2; ++x) {
      const size_t m = (size_t)m0 + 8 * w + tt + x;
      const bf16_t* qb = p.P + m * DIN + C_Q + hd * 64 + 4 * j4;
      const bf16_t* kb = p.P + m * DIN + C_K + (hd & 3) * 64 + 4 * j4;
#pragma unroll
      for (int qq = 0; qq < 4; ++qq) { uq[x][qq] = *(const uint2*)(qb + 16 * qq); uk[x][qq] = *(const uint2*)(kb + 16 * qq); }
    }
#pragma unroll
    for (int x = 0; x < 2; ++x) {
      const int tok = 8 * w + tt + x;
      const size_t m = (size_t)m0 + tok;
      const int t = t0 + tok;
      const bool lat = t >= CTXL;
      const int nn = t - CTXL;
      const int rowp = (nn >> 6) & 63, colp = nn & 63;
      qk_finish(uq[x], p.P + m * DIN + C_Q + hd * 64 + 4 * j4, gq, p.rope, lat, rowp, colp, j4, 0.125f * 1.4426950408889634f, dry);
      if (lane < 16) qk_finish(uk[x], p.P + m * DIN + C_K + hd * 64 + 4 * j4, gk, p.rope, lat, rowp, colp, j4, 1.f, dry);
    }
  }
}

DI void vt_item(const Params& p, int tile, char* smem, bool dry) {
  const int tid = opaque_tid();
  const int m0 = tile * 64;
  bf16_t* vs = (bf16_t*)smem;
#pragma unroll
  for (int i = 0; i < 8; ++i) {
    int c = tid + 256 * i;
    int tok = c >> 5, cc = c & 31;
    uint4 v = *(const uint4*)(p.P + (size_t)(m0 + tok) * DIN + C_V + cc * 8);
    *(uint4*)(vs + tok * 264 + cc * 8) = v;
  }
  __syncthreads();
  {
    const int R = tid;
    bf16_t* dst = p.P + (size_t)(m0 + (R >> 2)) * DIN + C_V + (R & 3) * 64;
#pragma unroll
    for (int c8 = 0; c8 < 8; ++c8) {
      uint4 o;
      const int sa = (2 * c8) & 3, sb = (2 * c8 + 1) & 3;
      const int ta = ((c8 * 8) & ~12) | ((sa == 1 ? 2 : (sa == 2 ? 1 : sa)) << 2);
      const int tb = ((c8 * 8 + 4) & ~12) | ((sb == 1 ? 2 : (sb == 2 ? 1 : sb)) << 2);
      unsigned e0 = vs[(ta + 0) * 264 + R], e1 = vs[(ta + 1) * 264 + R], e2 = vs[(ta + 2) * 264 + R], e3 = vs[(ta + 3) * 264 + R];
      unsigned e4 = vs[(tb + 0) * 264 + R], e5 = vs[(tb + 1) * 264 + R], e6 = vs[(tb + 2) * 264 + R], e7 = vs[(tb + 3) * 264 + R];
      o.x = e0 | (e1 << 16); o.y = e2 | (e3 << 16); o.z = e4 | (e5 << 16); o.w = e6 | (e7 << 16);
      if (!dry) *(uint4*)(dst + c8 * 8) = o;
    }
  }
  __syncthreads();
}

DI float fold_range(const float2* ag, int first, int count, int step, float h) {
  for (int base = 0; base < count; base += 16) {
    float2 v[16];
#pragma unroll
    for (int i = 0; i < 16; ++i) {
      const int k = base + i;
      const int c = first + step * (k < count ? k : count - 1);
      v[i] = ag[(size_t)c * 1024];
    }
#pragma unroll
    for (int i = 0; i < 16; ++i) if (base + i < count) h = v[i].x * h + v[i].y;
  }
  return h;
}

DI void lru_item(const Params& p, int l, int b, int chunk, int blk, int pass, char* smem, bool dry) {
  const int item_index = (b * NCHUNK + chunk) * 16 + blk;
  float* ucf = (float*)smem;
  bf16_t* ucb = (bf16_t*)(smem + 16384);
  bf16_t* us = (bf16_t*)(smem + 25600);
  float* ybuf = (float*)(smem + 34304);
  const int tid = opaque_tid(), w = tid >> 6, lane = tid & 63, r = lane & 31, hh = lane >> 5;
  const int t0 = chunk * 64;
  const size_t rowbase = (size_t)b * TOK;
  const int seg_lo = (t0 < CTXL) ? 0 : CTXL, seg_hi = (t0 < CTXL) ? CTXL : TOK;
  const int dir = w >> 1, chh = w & 1;
  const int jj = 32 * chh + r;
  const int gch = blk * 64 + jj;

  float hin = 0.f;
  if (pass == 2) {
    const float2* ag = (const float2*)p.agg + ((size_t)(b * 2 + dir) * NCHUNK) * 1024 + gch;
    if (dir == 0) {
      hin = fold_range(ag, 0, chunk, 1, hin);
    } else if (chunk < 4) {
      hin = fold_range(ag, 3, 3 - chunk, -1, hin);
    } else {
      hin = fold_range(ag, 3, 4, -1, hin);
      hin = fold_range(ag, NCHUNK - 1, NCHUNK - 1 - chunk, -1, hin);
    }
  }
  f32x16 ar[2], ai[2];
#pragma unroll
  for (int T = 0; T < 2; ++T)
#pragma unroll
    for (int i = 0; i < 16; ++i) { ar[T][i] = 0.f; ai[T][i] = 0.f; }
  bf16_t* labp = p.lab + (size_t)item_index * 16384 + dir * 8192 + jj * 64;
  if (pass == 1) {
    bf16x8 wbr[4], wbi[4];
    {
      const bf16_t* gw = p.Wg + (size_t)((dir * 2 + 0) * 16 + blk) * 4096 + jj * 64 + 8 * hh;
  #pragma unroll
      for (int s = 0; s < 4; ++s) { wbr[s] = *(const bf16x8*)(gw + 16 * s); wbi[s] = *(const bf16x8*)(gw + 16 * 4096 + 16 * s); }
    }
    const float brr = p.gate_b[((l * 2 + dir) * 2 + 0) * 1024 + gch];
    const float bii = p.gate_b[((l * 2 + dir) * 2 + 1) * 1024 + gch];
    const float xl = -p.lam[(l * 2 + dir) * 1024 + gch];

    for (int c = tid; c < 67 * 8; c += 256) {
      int rr = c >> 3, kc = c & 7;
      int t = t0 - 2 + rr;
      uint4 v = uint4{0u, 0u, 0u, 0u};
      if (t >= seg_lo && t < seg_hi) v = *(const uint4*)(p.P + (rowbase + t) * DIN + C_U + blk * 64 + kc * 8);
      *(uint4*)(us + rr * 64 + kc * 8) = v;
    }
    __syncthreads();
    {
      const int ch = tid & 63, tg = tid >> 6;
      const float* cw = p.conv_w + (size_t)l * 4 * 1024 + blk * 64 + ch;
      const float w0 = cw[0], w1 = cw[1024], w2 = cw[2048], w3 = cw[3072];
      const float cb = p.conv_b[l * 1024 + blk * 64 + ch];
      float x0 = bf2f(us[(16 * tg + 0) * 64 + ch]), x1 = bf2f(us[(16 * tg + 1) * 64 + ch]), x2 = bf2f(us[(16 * tg + 2) * 64 + ch]);
  #pragma unroll
      for (int i = 0; i < 16; ++i) {
        float x3 = bf2f(us[(16 * tg + i + 3) * 64 + ch]);
        float o = x0 * w0;
        o += x1 * w1; o += x2 * w2; o += x3 * w3; o += cb;
        const int tok = 16 * tg + i;
        ucf[tok * 64 + ch] = o;
        ucb[tok * 72 + ch] = (bf16_t)f2bf(o);
        x0 = x1; x1 = x2; x2 = x3;
      }
    }
    __syncthreads();
    {
  #pragma unroll
      for (int s = 0; s < 4; ++s) {
        const bf16x8 br = wbr[s];
        const bf16x8 bi = wbi[s];
  #pragma unroll
        for (int T = 0; T < 2; ++T) {
          bf16x8 a = *(const bf16x8*)(ucb + (32 * T + r) * 72 + 16 * s + 8 * hh);
          ar[T] = mfma32(a, br, ar[T]);
          ai[T] = mfma32(a, bi, ai[T]);
        }
      }
    }
    {
      const float sp = fmaxf(xl, 0.f) + log1pf(expf(-fabsf(xl)));
  #pragma unroll
      for (int T = 0; T < 2; ++T)
  #pragma unroll
        for (int half = 0; half < 2; ++half) {
          float lv[8], bv[8];
  #pragma unroll
          for (int e = 0; e < 8; ++e) {
            const int reg = 8 * half + e;
            const int t = 32 * T + (reg & 3) + 8 * (reg >> 2) + 4 * hh;
            const float ucv = ucf[t * 64 + jj];
            const float rg = sigm(ar[T][reg] + brr);
            const float ig = sigm(ai[T][reg] + bii);
            const float la2 = (-8.f * 1.4426950408889634f) * rg * sp;
            const float a = __builtin_amdgcn_exp2f(la2);
            lv[e] = la2;
            bv[e] = __builtin_amdgcn_sqrtf(fmaxf(1.f - a * a, 0.f)) * (ig * ucv);
          }
          uint4 pl, pbv;
          pl.x = pack2(lv[0], lv[1]); pl.y = pack2(lv[2], lv[3]); pl.z = pack2(lv[4], lv[5]); pl.w = pack2(lv[6], lv[7]);
          pbv.x = pack2(bv[0], bv[1]); pbv.y = pack2(bv[2], bv[3]); pbv.z = pack2(bv[4], bv[5]); pbv.w = pack2(bv[6], bv[7]);
          {
            bf16_t* lp = labp + 32 * T + 16 * half + 4 * hh;
            *(uint2*)(lp) = uint2{pl.x, pl.y};
            *(uint2*)(lp + 8) = uint2{pl.z, pl.w};
            *(uint2*)(lp + 4096) = uint2{pbv.x, pbv.y};
            *(uint2*)(lp + 4096 + 8) = uint2{pbv.z, pbv.w};
          }
          ar[T][8 * half + 0] = __builtin_amdgcn_exp2f(bflo(pl.x)); ar[T][8 * half + 1] = __builtin_amdgcn_exp2f(bfhi(pl.x));
          ar[T][8 * half + 2] = __builtin_amdgcn_exp2f(bflo(pl.y)); ar[T][8 * half + 3] = __builtin_amdgcn_exp2f(bfhi(pl.y));
          ar[T][8 * half + 4] = __builtin_amdgcn_exp2f(bflo(pl.z)); ar[T][8 * half + 5] = __builtin_amdgcn_exp2f(bfhi(pl.z));
          ar[T][8 * half + 6] = __builtin_amdgcn_exp2f(bflo(pl.w)); ar[T][8 * half + 7] = __builtin_amdgcn_exp2f(bfhi(pl.w));
          ai[T][8 * half + 0] = bflo(pbv.x); ai[T][8 * half + 1] = bfhi(pbv.x); ai[T][8 * half + 2] = bflo(pbv.y); ai[T][8 * half + 3] = bfhi(pbv.y);
          ai[T][8 * half + 4] = bflo(pbv.z); ai[T][8 * half + 5] = bfhi(pbv.z); ai[T][8 * half + 6] = bflo(pbv.w); ai[T][8 * half + 7] = bfhi(pbv.w);
        }
    }
  }
  float cA[8], cB[8];
#pragma unroll
  for (int k = 0; k < 8; ++k) {
    const int T = k >> 2, g = k & 3;
    float A = 1.f, B = 0.f;
    if (dir == 0) {
#pragma unroll
      for (int e = 0; e < 4; ++e) { float a = ar[T][4 * g + e]; B = a * B + ai[T][4 * g + e]; A *= a; }
    } else {
#pragma unroll
      for (int e = 3; e >= 0; --e) { float a = ar[T][4 * g + e]; B = a * B + ai[T][4 * g + e]; A *= a; }
    }
    cA[k] = A; cB[k] = B;
  }
  float loA[8], loB[8], hiA[8], hiB[8];
#pragma unroll
  for (int k = 0; k < 8; ++k) {
    float pA = __shfl_xor(cA[k], 32), pB = __shfl_xor(cB[k], 32);
    loA[k] = hh ? pA : cA[k]; loB[k] = hh ? pB : cB[k];
    hiA[k] = hh ? cA[k] : pA; hiB[k] = hh ? cB[k] : pB;
  }
  if (pass == 1) {
    float A = 1.f, B = 0.f;
    if (dir == 0) {
#pragma unroll
      for (int k = 0; k < 8; ++k) { B = loA[k] * B + loB[k]; A *= loA[k]; B = hiA[k] * B + hiB[k]; A *= hiA[k]; }
    } else {
#pragma unroll
      for (int k = 7; k >= 0; --k) { B = hiA[k] * B + hiB[k]; A *= hiA[k]; B = loA[k] * B + loB[k]; A *= loA[k]; }
    }
    if (hh == 0) {
      float2* ag = (float2*)p.agg + ((size_t)(b * 2 + dir) * NCHUNK + chunk) * 1024 + gch;
      *ag = float2{A, B};
    }
    __syncthreads();
    return;
  }
  float st[8];
  {
    float h = hin;
    if (dir == 0) {
#pragma unroll
      for (int k = 0; k < 8; ++k) {
        float s_lo = h; h = loA[k] * h + loB[k];
        float s_hi = h; h = hiA[k] * h + hiB[k];
        st[k] = hh ? s_hi : s_lo;
      }
    } else {
#pragma unroll
      for (int k = 7; k >= 0; --k) {
        float s_hi = h; h = hiA[k] * h + hiB[k];
        float s_lo = h; h = loA[k] * h + loB[k];
        st[k] = hh ? s_hi : s_lo;
      }
    }
  }
#pragma unroll
  for (int k = 0; k < 8; ++k) {
    const int T = k >> 2, g = k & 3;
    float h = st[k];
    if (dir == 0) {
#pragma unroll
      for (int e = 0; e < 4; ++e) { h = ar[T][4 * g + e] * h + ai[T][4 * g + e]; ar[T][4 * g + e] = h; }
    } else {
#pragma unroll
      for (int e = 3; e >= 0; --e) { h = ar[T][4 * g + e] * h + ai[T][4 * g + e]; ar[T][4 * g + e] = h; }
    }
  }
  if (dir == 0) {
#pragma unroll
    for (int T = 0; T < 2; ++T)
#pragma unroll
      for (int reg = 0; reg < 16; ++reg) {
        const int t = 32 * T + (reg & 3) + 8 * (reg >> 2) + 4 * hh;
        ybuf[t * 64 + jj] = ar[T][reg];
      }
  }
  __syncthreads();
  if (dir == 1) {
#pragma unroll
    for (int T = 0; T < 2; ++T)
#pragma unroll
      for (int reg = 0; reg < 16; ++reg) {
        const int t = 32 * T + (reg & 3) + 8 * (reg >> 2) + 4 * hh;
        ybuf[t * 64 + jj] += ar[T][reg];
      }
  }
  __syncthreads();
  {
    const int tok = tid >> 2, cg4 = tid & 3;
    bf16_t* gp = p.P + (rowbase + t0 + tok) * DIN + C_GB + blk * 64 + cg4 * 16;
    const float* yp = ybuf + tok * 64 + cg4 * 16;
#pragma unroll
    for (int hq = 0; hq < 2; ++hq) {
      uint4 g = *(const uint4*)(gp + 8 * hq);
      uint4 o;
      o.x = pack2(yp[8 * hq + 0] * silu(bflo(g.x)), yp[8 * hq + 1] * silu(bfhi(g.x)));
      o.y = pack2(yp[8 * hq + 2] * silu(bflo(g.y)), yp[8 * hq + 3] * silu(bfhi(g.y)));
      o.z = pack2(yp[8 * hq + 4] * silu(bflo(g.z)), yp[8 * hq + 5] * silu(bfhi(g.z)));
      o.w = pack2(yp[8 * hq + 6] * silu(bflo(g.w)), yp[8 * hq + 7] * silu(bfhi(g.w)));
      if (!dry) *(uint4*)(gp + 8 * hq) = o;
    }
  }
  __syncthreads();
}

DI void lru1_run(const Params& p, int l, int j0, int nb, int n_l, char* smem) {
  if (j0 >= n_l) return;
  float* ucf = (float*)smem;
  bf16_t* ucb = (bf16_t*)(smem + 16384);
  bf16_t* us = (bf16_t*)(smem + 25600);
  typedef unsigned u32x4 __attribute__((ext_vector_type(4)));
  const int tid = opaque_tid(), w = tid >> 6, lane = tid & 63, r = lane & 31, hh = lane >> 5;
  const int dir = w >> 1, chh = w & 1;
  const int jj = 32 * chh + r;
  const int blk = j0 & 15;
  const int gch = blk * 64 + jj;
  bf16x8 wbr[4], wbi[4];
  {
    const bf16_t* gw = p.Wg + (size_t)((dir * 2 + 0) * 16 + blk) * 4096 + jj * 64 + 8 * hh;
#pragma unroll
    for (int s = 0; s < 4; ++s) { wbr[s] = *(const bf16x8*)(gw + 16 * s); wbi[s] = *(const bf16x8*)(gw + 16 * 4096 + 16 * s); }
  }
  const float brr = p.gate_b[((l * 2 + dir) * 2 + 0) * 1024 + gch];
  const float bii = p.gate_b[((l * 2 + dir) * 2 + 1) * 1024 + gch];
  const float xl = -p.lam[(l * 2 + dir) * 1024 + gch];
  const float sp = fmaxf(xl, 0.f) + log1pf(expf(-fabsf(xl)));
  const int cch = tid & 63, tg = tid >> 6;
  const float* cw = p.conv_w + (size_t)l * 4 * 1024 + blk * 64 + cch;
  const float w0 = cw[0], w1 = cw[1024], w2 = cw[2048], w3 = cw[3072];
  const float cb = p.conv_b[l * 1024 + blk * 64 + cch];
  u32x4 pu0, pu1, pu2;
#define LRU_LOADU(J) { \
    const int rest_ = (J) >> 4; const int chunk_ = rest_ % NCHUNK, b_ = rest_ / NCHUNK; const int t0_ = chunk_ * 64; \
    const int lo_ = (t0_ < CTXL) ? 0 : CTXL, hi_ = (t0_ < CTXL) ? CTXL : TOK; \
    const bf16_t* ub_ = p.P + ((size_t)b_ * TOK) * DIN + C_U + blk * 64; \
    { const int c_ = tid; const int t_ = t0_ - 2 + (c_ >> 3); pu0 = u32x4{0u, 0u, 0u, 0u}; if (t_ >= lo_ && t_ < hi_) pu0 = *(const u32x4*)(ub_ + (size_t)t_ * DIN + (c_ & 7) * 8); } \
    { const int c_ = tid + 256; const int t_ = t0_ - 2 + (c_ >> 3); pu1 = u32x4{0u, 0u, 0u, 0u}; if (t_ >= lo_ && t_ < hi_) pu1 = *(const u32x4*)(ub_ + (size_t)t_ * DIN + (c_ & 7) * 8); } \
    { const int c_ = tid + 512; const int t_ = t0_ - 2 + (c_ >> 3); pu2 = u32x4{0u, 0u, 0u, 0u}; if (c_ < 536 && t_ >= lo_ && t_ < hi_) pu2 = *(const u32x4*)(ub_ + (size_t)t_ * DIN + (c_ & 7) * 8); } }
  LRU_LOADU(j0)
  for (int j = j0; j < n_l; j += nb) {
    const int rest = j >> 4;
    const int chunk = rest % NCHUNK, b = rest / NCHUNK;
    const int item_index = (b * NCHUNK + chunk) * 16 + blk;
    *(u32x4*)(us + (tid >> 3) * 64 + (tid & 7) * 8) = pu0;
    *(u32x4*)(us + ((tid + 256) >> 3) * 64 + (tid & 7) * 8) = pu1;
    if (tid + 512 < 536) *(u32x4*)(us + ((tid + 512) >> 3) * 64 + (tid & 7) * 8) = pu2;
    __syncthreads();
    if (j + nb < n_l) LRU_LOADU(j + nb)
    {
      float x0 = bf2f(us[(16 * tg + 0) * 64 + cch]), x1 = bf2f(us[(16 * tg + 1) * 64 + cch]), x2 = bf2f(us[(16 * tg + 2) * 64 + cch]);
#pragma unroll
      for (int i = 0; i < 16; ++i) {
        float x3 = bf2f(us[(16 * tg + i + 3) * 64 + cch]);
        float o = x0 * w0;
        o += x1 * w1; o += x2 * w2; o += x3 * w3; o += cb;
        const int tok = 16 * tg + i;
        ucf[tok * 64 + cch] = o;
        ucb[tok * 72 + cch] = (bf16_t)f2bf(o);
        x0 = x1; x1 = x2; x2 = x3;
      }
    }
    __syncthreads();
    f32x16 ar[2], ai[2];
#pragma unroll
    for (int T = 0; T < 2; ++T)
#pragma unroll
      for (int i = 0; i < 16; ++i) { ar[T][i] = 0.f; ai[T][i] = 0.f; }
#pragma unroll
    for (int s = 0; s < 4; ++s)
#pragma unroll
      for (int T = 0; T < 2; ++T) {
        bf16x8 a = *(const bf16x8*)(ucb + (32 * T + r) * 72 + 16 * s + 8 * hh);
        ar[T] = mfma32(a, wbr[s], ar[T]);
        ai[T] = mfma32(a, wbi[s], ai[T]);
      }
    bf16_t* labp = p.lab + (size_t)item_index * 16384 + dir * 8192 + jj * 64;
#pragma unroll
    for (int T = 0; T < 2; ++T)
#pragma unroll
      for (int half = 0; half < 2; ++half) {
        float lv[8], bv[8];
#pragma unroll
        for (int e = 0; e < 8; ++e) {
          const int reg = 8 * half + e;
          const int t = 32 * T + (reg & 3) + 8 * (reg >> 2) + 4 * hh;
          const float ucv = ucf[t * 64 + jj];
          const float rg = sigm(ar[T][reg] + brr);
          const float ig = sigm(ai[T][reg] + bii);
          const float la2 = (-8.f * 1.4426950408889634f) * rg * sp;
          const float a = __builtin_amdgcn_exp2f(la2);
          lv[e] = la2;
          bv[e] = __builtin_amdgcn_sqrtf(fmaxf(1.f - a * a, 0.f)) * (ig * ucv);
        }
        uint4 pl, pbv;
        pl.x = pack2(lv[0], lv[1]); pl.y = pack2(lv[2], lv[3]); pl.z = pack2(lv[4], lv[5]); pl.w = pack2(lv[6], lv[7]);
        pbv.x = pack2(bv[0], bv[1]); pbv.y = pack2(bv[2], bv[3]); pbv.z = pack2(bv[4], bv[5]); pbv.w = pack2(bv[6], bv[7]);
        {
          bf16_t* lp = labp + 32 * T + 16 * half + 4 * hh;
          *(uint2*)(lp) = uint2{pl.x, pl.y};
          *(uint2*)(lp + 8) = uint2{pl.z, pl.w};
          *(uint2*)(lp + 4096) = uint2{pbv.x, pbv.y};
          *(uint2*)(lp + 4096 + 8) = uint2{pbv.z, pbv.w};
        }
        ar[T][8 * half + 0] = __builtin_amdgcn_exp2f(bflo(pl.x)); ar[T][8 * half + 1] = __builtin_amdgcn_exp2f(bfhi(pl.x));
        ar[T][8 * half + 2] = __builtin_amdgcn_exp2f(bflo(pl.y)); ar[T][8 * half + 3] = __builtin_amdgcn_exp2f(bfhi(pl.y));
        ar[T][8 * half + 4] = __builtin_amdgcn_exp2f(bflo(pl.z)); ar[T][8 * half + 5] = __builtin_amdgcn_exp2f(bfhi(pl.z));
        ar[T][8 * half + 6] = __builtin_amdgcn_exp2f(bflo(pl.w)); ar[T][8 * half + 7] = __builtin_amdgcn_exp2f(bfhi(pl.w));
        ai[T][8 * half + 0] = bflo(pbv.x); ai[T][8 * half + 1] = bfhi(pbv.x); ai[T][8 * half + 2] = bflo(pbv.y); ai[T][8 * half + 3] = bfhi(pbv.y);
        ai[T][8 * half + 4] = bflo(pbv.z); ai[T][8 * half + 5] = bfhi(pbv.z); ai[T][8 * half + 6] = bflo(pbv.w); ai[T][8 * half + 7] = bfhi(pbv.w);
      }
    float cA[8], cB[8];
#pragma unroll
    for (int k = 0; k < 8; ++k) {
      const int T = k >> 2, g = k & 3;
      float A = 1.f, B = 0.f;
      if (dir == 0) {
#pragma unroll
        for (int e = 0; e < 4; ++e) { float a = ar[T][4 * g + e]; B = a * B + ai[T][4 * g + e]; A *= a; }
      } else {
#pragma unroll
        for (int e = 3; e >= 0; --e) { float a = ar[T][4 * g + e]; B = a * B + ai[T][4 * g + e]; A *= a; }
      }
      cA[k] = A; cB[k] = B;
    }
    float A = 1.f, B = 0.f;
    if (dir == 0) {
#pragma unroll
      for (int k = 0; k < 8; ++k) {
        const float pA = __shfl_xor(cA[k], 32), pB = __shfl_xor(cB[k], 32);
        const float loA = hh ? pA : cA[k], loB = hh ? pB : cB[k], hiA = hh ? cA[k] : pA, hiB = hh ? cB[k] : pB;
        B = loA * B + loB; A *= loA; B = hiA * B + hiB; A *= hiA;
      }
    } else {
#pragma unroll
      for (int k = 7; k >= 0; --k) {
        const float pA = __shfl_xor(cA[k], 32), pB = __shfl_xor(cB[k], 32);
        const float loA = hh ? pA : cA[k], loB = hh ? pB : cB[k], hiA = hh ? cA[k] : pA, hiB = hh ? cB[k] : pB;
        B = hiA * B + hiB; A *= hiA; B = loA * B + loB; A *= loA;
      }
    }
    if (hh == 0) {
      float2* ag = (float2*)p.agg + ((size_t)(b * 2 + dir) * NCHUNK + chunk) * 1024 + gch;
      *ag = float2{A, B};
    }
    __syncthreads();
  }
#undef LRU_LOADU
}

DI void lru2_wave(const Params& p, int wi, bool last, bool dry) {
  const int lane = opaque_tid() & 63;
  const int blk = wi & 15, rest = wi >> 4;
  const int chunk = rest % NCHUNK, b = rest / NCHUNK;
  if (last && chunk < 4) return;
  const int gch = blk * 64 + lane;
  const float2* ag0 = (const float2*)p.agg + ((size_t)(b * 2 + 0) * NCHUNK) * 1024 + gch;
  const float2* ag1 = (const float2*)p.agg + ((size_t)(b * 2 + 1) * NCHUNK) * 1024 + gch;
  float hf = fold_range(ag0, 0, chunk, 1, 0.f);
  float hr = 0.f;
  if (chunk < 4) {
    hr = fold_range(ag1, 3, 3 - chunk, -1, hr);
  } else {
    hr = fold_range(ag1, 3, 4, -1, hr);
    hr = fold_range(ag1, NCHUNK - 1, NCHUNK - 1 - chunk, -1, hr);
  }
  const bf16_t* lp = p.lab + (size_t)wi * 16384 + lane * 64;
  float y[64];
  {
    uint4 la[8], bb[8];
#pragma unroll
    for (int q = 0; q < 8; ++q) { la[q] = *(const uint4*)(lp + q * 8); bb[q] = *(const uint4*)(lp + 4096 + q * 8); }
    float h = hf;
#pragma unroll
    for (int q = 0; q < 8; ++q) {
      h = __builtin_amdgcn_exp2f(bflo(la[q].x)) * h + bflo(bb[q].x); y[8 * q + 0] = h;
      h = __builtin_amdgcn_exp2f(bfhi(la[q].x)) * h + bfhi(bb[q].x); y[8 * q + 1] = h;
      h = __builtin_amdgcn_exp2f(bflo(la[q].y)) * h + bflo(bb[q].y); y[8 * q + 2] = h;
      h = __builtin_amdgcn_exp2f(bfhi(la[q].y)) * h + bfhi(bb[q].y); y[8 * q + 3] = h;
      h = __builtin_amdgcn_exp2f(bflo(la[q].z)) * h + bflo(bb[q].z); y[8 * q + 4] = h;
      h = __builtin_amdgcn_exp2f(bfhi(la[q].z)) * h + bfhi(bb[q].z); y[8 * q + 5] = h;
      h = __builtin_amdgcn_exp2f(bflo(la[q].w)) * h + bflo(bb[q].w); y[8 * q + 6] = h;
      h = __builtin_amdgcn_exp2f(bfhi(la[q].w)) * h + bfhi(bb[q].w); y[8 * q + 7] = h;
    }
  }
  {
    uint4 la[8], bb[8];
#pragma unroll
    for (int q = 0; q < 8; ++q) { la[q] = *(const uint4*)(lp + 8192 + q * 8); bb[q] = *(const uint4*)(lp + 8192 + 4096 + q * 8); }
    float h = hr;
#pragma unroll
    for (int q = 7; q >= 0; --q) {
      h = __builtin_amdgcn_exp2f(bfhi(la[q].w)) * h + bfhi(bb[q].w); y[8 * q + 7] += h;
      h = __builtin_amdgcn_exp2f(bflo(la[q].w)) * h + bflo(bb[q].w); y[8 * q + 6] += h;
      h = __builtin_amdgcn_exp2f(bfhi(la[q].z)) * h + bfhi(bb[q].z); y[8 * q + 5] += h;
      h = __builtin_amdgcn_exp2f(bflo(la[q].z)) * h + bflo(bb[q].z); y[8 * q + 4] += h;
      h = __builtin_amdgcn_exp2f(bfhi(la[q].y)) * h + bfhi(bb[q].y); y[8 * q + 3] += h;
      h = __builtin_amdgcn_exp2f(bflo(la[q].y)) * h + bflo(bb[q].y); y[8 * q + 2] += h;
      h = __builtin_amdgcn_exp2f(bfhi(la[q].x)) * h + bfhi(bb[q].x); y[8 * q + 1] += h;
      h = __builtin_amdgcn_exp2f(bflo(la[q].x)) * h + bflo(bb[q].x); y[8 * q + 0] += h;
    }
  }
  bf16_t* gp = p.P + ((size_t)b * TOK + (size_t)chunk * 64) * DIN + C_GB + blk * 64 + lane;
#pragma unroll
  for (int t0 = 0; t0 < 64; t0 += 16) {
    bf16_t g[16];
#pragma unroll
    for (int i = 0; i < 16; ++i) g[i] = gp[(size_t)(t0 + i) * DIN];
#pragma unroll
    for (int i = 0; i < 16; ++i) {
      const float o = y[t0 + i] * silu(bf2f(g[i]));
      if (!dry) gp[(size_t)(t0 + i) * DIN] = (bf16_t)f2bf(o);
    }
  }
}

template <bool FAST>
DI void attn_item_t(const Params& p, int b, int hq, int qt0, int nkeys, char* smem, bool dry) {
  typedef bf16_t (*kv_t)[64][72];
  kv_t Ks = (kv_t)smem;
  kv_t Vs = (kv_t)(smem + 2 * 64 * 72 * 2);
  const int tid = opaque_tid(), w = tid >> 6, lane = tid & 63, r = lane & 31, hh = lane >> 5;
  const int kvh = hq >> 2;
  const size_t rowbase = (size_t)b * TOK;
  const size_t mq = rowbase + qt0 + 32 * w + r;
  bf16_t* prow = p.P + mq * DIN;
  bf16x8 qf[4];
#pragma unroll
  for (int s = 0; s < 4; ++s) qf[s] = *(const bf16x8*)(prow + C_Q + hq * 64 + 16 * s + 8 * hh);
  const int lr = tid >> 3, lc = tid & 7;
  const bf16_t* kptr = p.P + (rowbase + lr) * DIN + C_K + kvh * 64 + lc * 8;
  const bf16_t* vptr = p.P + (rowbase + kvh * 16 + (lr >> 2)) * DIN + C_V + (lr & 3) * 64 + lc * 8;
  uint4 rk0, rk1, rv0, rv1;
  rk0 = *(const uint4*)(kptr); rk1 = *(const uint4*)(kptr + (size_t)32 * DIN);
  rv0 = *(const uint4*)(vptr); rv1 = *(const uint4*)(vptr + (size_t)8 * DIN);
  *(uint4*)&Ks[0][lr][lc * 8] = rk0; *(uint4*)&Ks[0][lr + 32][lc * 8] = rk1;
  *(uint4*)&Vs[0][lr][lc * 8] = rv0; *(uint4*)&Vs[0][lr + 32][lc * 8] = rv1;
  __syncthreads();
  f32x16 negm;
#pragma unroll
  for (int i = 0; i < 16; ++i) negm[i] = 0.f;
  if (!FAST) {
    f32x16 s0, s1;
#pragma unroll
    for (int i = 0; i < 16; ++i) { s0[i] = 0.f; s1[i] = 0.f; }
#pragma unroll
    for (int s = 0; s < 4; ++s) {
      bf16x8 a0 = *(const bf16x8*)&Ks[0][r][16 * s + 8 * hh];
      bf16x8 a1 = *(const bf16x8*)&Ks[0][32 + r][16 * s + 8 * hh];
      s0 = mfma32(a0, qf[s], s0);
      s1 = mfma32(a1, qf[s], s1);
    }
    float mx = fmaxf(s0[0], s1[0]);
#pragma unroll
    for (int i = 1; i < 16; ++i) mx = fmaxf(fmaxf(mx, s0[i]), s1[i]);
    mx = fmaxf(mx, __shfl_xor(mx, 32));
#pragma unroll
    for (int i = 0; i < 16; ++i) negm[i] = -mx;
  }
  float lrun = 0.f;
  f32x16 o0, o1;
#pragma unroll
  for (int i = 0; i < 16; ++i) { o0[i] = 0.f; o1[i] = 0.f; }
  const int ntile = nkeys >> 6;
  for (int t = 0; t < ntile; ++t) {
    const int cur = t & 1;
    if (t + 1 < ntile) {
      const size_t ko = (size_t)(t + 1) * 64 * DIN;
      rk0 = *(const uint4*)(kptr + ko); rk1 = *(const uint4*)(kptr + ko + (size_t)32 * DIN);
      rv0 = *(const uint4*)(vptr + ko); rv1 = *(const uint4*)(vptr + ko + (size_t)8 * DIN);
    }
    f32x16 s0, s1;
    __builtin_amdgcn_s_setprio(1);
    {
      bf16x8 a0 = *(const bf16x8*)&Ks[cur][r][8 * hh];
      bf16x8 a1 = *(const bf16x8*)&Ks[cur][32 + r][8 * hh];
      if (FAST) {
        f32x16 z;
#pragma unroll
        for (int i = 0; i < 16; ++i) z[i] = 0.f;
        s0 = mfma32(a0, qf[0], z);
        s1 = mfma32(a1, qf[0], z);
      } else {
        s0 = mfma32(a0, qf[0], negm);
        s1 = mfma32(a1, qf[0], negm);
      }
    }
#pragma unroll
    for (int s = 1; s < 4; ++s) {
      bf16x8 a0 = *(const bf16x8*)&Ks[cur][r][16 * s + 8 * hh];
      bf16x8 a1 = *(const bf16x8*)&Ks[cur][32 + r][16 * s + 8 * hh];
      s0 = mfma32(a0, qf[s], s0);
      s1 = mfma32(a1, qf[s], s1);
    }
    __builtin_amdgcn_s_setprio(0);
    float mx = 0.f;
    if (!FAST) {
      mx = fmaxf(s0[0], s1[0]);
#pragma unroll
      for (int i = 1; i < 16; ++i) mx = fmaxf(fmaxf(mx, s0[i]), s1[i]);
    }
    float rs0 = 0.f, rs1 = 0.f;
#pragma unroll
    for (int i = 0; i < 16; ++i) { s0[i] = __builtin_amdgcn_exp2f(s0[i]); rs0 += s0[i]; }
#pragma unroll
    for (int i = 0; i < 16; ++i) { s1[i] = __builtin_amdgcn_exp2f(s1[i]); rs1 += s1[i]; }
    lrun += rs0 + rs1;
    bf16x8 pb[2][2];
#pragma unroll
    for (int s = 0; s < 2; ++s) {
      unsigned u0 = pack2(s0[8 * s + 0], s0[8 * s + 1]), u1 = pack2(s0[8 * s + 2], s0[8 * s + 3]);
      unsigned u2 = pack2(s0[8 * s + 4], s0[8 * s + 5]), u3 = pack2(s0[8 * s + 6], s0[8 * s + 7]);
      uint4 uu = uint4{u0, u1, u2, u3};
      pb[0][s] = __builtin_bit_cast(bf16x8, uu);
      unsigned w0 = pack2(s1[8 * s + 0], s1[8 * s + 1]), w1 = pack2(s1[8 * s + 2], s1[8 * s + 3]);
      unsigned w2 = pack2(s1[8 * s + 4], s1[8 * s + 5]), w3 = pack2(s1[8 * s + 6], s1[8 * s + 7]);
      uint4 ww = uint4{w0, w1, w2, w3};
      pb[1][s] = __builtin_bit_cast(bf16x8, ww);
    }
#pragma unroll
    for (int kh = 0; kh < 2; ++kh)
#pragma unroll
      for (int s = 0; s < 2; ++s) {
        const int kc = 32 * kh + 16 * s + 8 * hh;
        bf16x8 va0 = *(const bf16x8*)&Vs[cur][r][kc];
        bf16x8 va1 = *(const bf16x8*)&Vs[cur][32 + r][kc];
        o0 = mfma32(va0, pb[kh][s], o0);
        o1 = mfma32(va1, pb[kh][s], o1);
      }
    if (!FAST && __builtin_amdgcn_ballot_w64(mx > 12.f) != 0ull) {
      const float mxp = fmaxf(mx, __shfl_xor(mx, 32));
      const float shift = mxp > 12.f ? mxp : 0.f;
      const float f = __builtin_amdgcn_exp2f(-shift);
      lrun *= f;
#pragma unroll
      for (int i = 0; i < 16; ++i) { o0[i] *= f; o1[i] *= f; negm[i] -= shift; }
    }
    if (t + 1 < ntile) {
      *(uint4*)&Ks[cur ^ 1][lr][lc * 8] = rk0; *(uint4*)&Ks[cur ^ 1][lr + 32][lc * 8] = rk1;
      *(uint4*)&Vs[cur ^ 1][lr][lc * 8] = rv0; *(uint4*)&Vs[cur ^ 1][lr + 32][lc * 8] = rv1;
    }
    __syncthreads();
  }
  const float ltot = lrun + __shfl_xor(lrun, 32);
  const float inv = 1.f / ltot;
#pragma unroll
  for (int dh = 0; dh < 2; ++dh)
#pragma unroll
    for (int g = 0; g < 4; ++g) {
      const int d0 = 32 * dh + 8 * g + 4 * hh;
      uint2 gau = *(const uint2*)(prow + C_GA + hq * 64 + d0);
      float v0 = (dh ? o1[4 * g + 0] : o0[4 * g + 0]) * inv * silu(bflo(gau.x));
      float v1 = (dh ? o1[4 * g + 1] : o0[4 * g + 1]) * inv * silu(bfhi(gau.x));
      float v2 = (dh ? o1[4 * g + 2] : o0[4 * g + 2]) * inv * silu(bflo(gau.y));
      float v3 = (dh ? o1[4 * g + 3] : o0[4 * g + 3]) * inv * silu(bfhi(gau.y));
      uint2 o; o.x = pack2(v0, v1); o.y = pack2(v2, v3);
      if (!dry) *(uint2*)(prow + C_Q + hq * 64 + d0) = o;
    }
}


DI void attn_item(const Params& p, int l, int b, int hq, int qt0, int nkeys, char* smem, bool dry) {
  const int lane = opaque_tid() & 63;
  float gq = fabsf(p.q_norm_g[l * 64 + lane]), gk = fabsf(p.k_norm_g[l * 64 + lane]);
#pragma unroll
  for (int off = 32; off >= 1; off >>= 1) { gq = fmaxf(gq, __shfl_xor(gq, off)); gk = fmaxf(gk, __shfl_xor(gk, off)); }
  const float bound = 64.f * 0.125f * 1.4426950408889634f * gq * gk * 1.01f;
  if (__builtin_amdgcn_readfirstlane(bound < 60.f ? 1 : 0)) attn_item_t<true>(p, b, hq, qt0, nkeys, smem, dry);
  else attn_item_t<false>(p, b, hq, qt0, nkeys, smem, dry);
}

#define XB_TMO      128
#define XB_XCNT(j)  (256  + 64 * (j))
#define XB_XSUB(j)  (1280 + 64 * (j))
#define XB_XGEN(j)  (2304 + 64 * (j))
#define XB_TOP      3328
#define XB_TOPGEN   3392
#define XCD_BAR_WORDS 3456
#define XB_SPIN_CAP (1u << 20)
#define LAS __attribute__((address_space(3)))
DI unsigned xb_ld(unsigned* p) { return __hip_atomic_load(p, __ATOMIC_RELAXED, __HIP_MEMORY_SCOPE_AGENT); }
DI unsigned xb_add(unsigned* p, unsigned v) { return __hip_atomic_fetch_add(p, v, __ATOMIC_RELAXED, __HIP_MEMORY_SCOPE_AGENT); }
DI unsigned xb_xcc_id() { return (unsigned)__builtin_amdgcn_s_getreg((3 << 11) | 20) & 0xFu; }
#define XB_SPIN(cond, bar) do { unsigned _sp = 0; while (cond) { __builtin_amdgcn_s_sleep(1); \
    if ((++_sp & 255u) == 0u) { if (xb_ld(&(bar)[XB_TMO])) break; if (_sp > XB_SPIN_CAP) { atomicAdd(&(bar)[XB_TMO], 1u); break; } } } } while (0)
struct XcdBarrier { unsigned* bar; unsigned x; volatile LAS unsigned* st; };
DI XcdBarrier xcd_barrier_post(unsigned* bar, volatile LAS unsigned* st) {
  XcdBarrier b; b.bar = bar; b.x = xb_xcc_id(); b.st = st;
  if (threadIdx.x == 0) (void)xb_add(&bar[XB_XCNT(b.x)], 1u);
  return b;
}
DI void xcd_barrier_complete(unsigned* bar, unsigned x, unsigned& nloc, unsigned& nx) {
  const unsigned G = gridDim.x * gridDim.y * gridDim.z;
  unsigned sum, cnt, mine, sp = 0u;
  for (;;) {
    sum = 0u; cnt = 0u; mine = 0u;
#pragma unroll
    for (unsigned j = 0; j < 16; ++j) { const unsigned c = xb_ld(&bar[XB_XCNT(j)]); sum += c; cnt += (c > 0u) ? 1u : 0u; mine = (j == x) ? c : mine; }
    if (sum == G) break;
    __builtin_amdgcn_s_sleep(1);
    if ((++sp & 255u) == 0u) { if (xb_ld(&bar[XB_TMO])) break; if (sp > XB_SPIN_CAP) { atomicAdd(&bar[XB_TMO], 1u); break; } }
  }
  nloc = mine > 0u ? mine : 1u; nx = cnt > 0u ? cnt : 1u;
}
DI void xcd_barrier(const XcdBarrier& b) {
  asm volatile("s_waitcnt vmcnt(0)" ::: "memory");
  __syncthreads();
  if (threadIdx.x == 0) {
    unsigned* bar = b.bar;
    __builtin_amdgcn_s_waitcnt(0);
    unsigned nloc = b.st[0], nx = b.st[1];
    if (nloc == 0u) { xcd_barrier_complete(bar, b.x, nloc, nx); b.st[0] = nloc; b.st[1] = nx; }
    const unsigned old = xb_add(&bar[XB_XSUB(b.x)], 1u);
    const unsigned gen = old / nloc;
    if (old + 1u == (gen + 1u) * nloc) {
      __builtin_amdgcn_fence(__ATOMIC_RELEASE, "agent");
      asm volatile("s_waitcnt vmcnt(0)" ::: "memory");
      const unsigned og = xb_add(&bar[XB_TOP], 1u);
      const unsigned tg = og / nx;
      if (og + 1u == (tg + 1u) * nx) xb_add(&bar[XB_TOPGEN], 1u);
      else XB_SPIN(xb_ld(&bar[XB_TOPGEN]) == tg, bar);
      __builtin_amdgcn_fence(__ATOMIC_ACQUIRE, "agent");
      xb_add(&bar[XB_XGEN(b.x)], 1u);
      asm volatile("s_waitcnt vmcnt(0)" ::: "memory");
    } else {
      XB_SPIN(xb_ld(&bar[XB_XGEN(b.x)]) == gen, bar);
      __builtin_amdgcn_fence(__ATOMIC_ACQUIRE, "agent");
      asm volatile("s_waitcnt vmcnt(0)" ::: "memory");
    }
  }
  __syncthreads();
}

DI void run_phase(const Params& p, int ph, char* smem, bool dry, int sel) {
  const int bid = blockIdx.x, nb = gridDim.x;
  if (ph == 0) {
    for (int it = bid; it < 769 + 1664 + 64; it += nb) {
      if (it < 768) mod_partial_item(p, it, smem);
      else if (it == 768) rope_item(p);
      else if (it < 769 + 1664) { const int f = it - 769; transpose_tile(p.w_in, 1024, DIN, p.Wt_in, HP, (f & 15) * 64, (f >> 4) * 64, smem); }
      else { const int mat = it - 769 - 1664; transpose_tile(p.gate_w + (size_t)mat * 4096, 64, 64, p.Wg + (size_t)mat * 4096, 64, 0, 0, smem); }
    }
    return;
  }
  if (ph == 1) {
    for (int it = bid; it < 240; it += nb) mod_reduce_item(p, it);
    return;
  }
  const int l = (ph - 2) / 6, k = (ph - 2) % 6;
  const bool last = (l == 3);
  if (k == 0) {
    const int n_tr = 16 * 104, n_g = 64;
    const int n_items = n_tr + n_g + MALL / 4;
    int it = bid;
    for (; it < n_tr + n_g; it += nb) {
      if (l == 0) continue;
      if (it < n_tr) {
        int rt = it & 15, ct = it >> 4;
        transpose_tile(p.w_in + (size_t)l * 1024 * DIN, 1024, DIN, p.Wt_in, HP, rt * 64, ct * 64, smem);
      } else {
        int mat = it - n_tr;
        transpose_tile(p.gate_w + (size_t)l * 262144 + (size_t)mat * 4096, 64, 64, p.Wg + (size_t)mat * 4096, 64, 0, 0, smem);
      }
    }
    norm_run(p, l, it - n_tr - n_g, nb, n_items - n_tr - n_g);
  } else if (k == 1) {
    if ((nb & 7) == 0) {
      const int xcd = bid & 7, rm = xcd >> 1, rn = xcd & 1;
      const int jstep = nb >> 3;
      int j = bid >> 3;
#define G1_ITEM(JJ, OUT) { int mi_, ni_; \
        if ((JJ) < 34 * 24) { const int ch_ = (JJ) / 272, rr_ = (JJ) % 272; mi_ = rr_ >> 3; ni_ = ch_ * 8 + (rr_ & 7); } \
        else { const int rr_ = (JJ) - 34 * 24; mi_ = rr_ >> 1; ni_ = 24 + (rr_ & 1); } \
        OUT = (34 * rm + mi_) * 52 + 26 * rn + ni_; }
      bool primed = false;
      for (; j < 34 * 26; j += jstep) {
        int item, nitem = -1;
        G1_ITEM(j, item)
        if (j + jstep < 34 * 26) G1_ITEM(j + jstep, nitem)
        g1_tile(p, item, smem, primed, nitem);
        primed = nitem >= 0;
      }
#undef G1_ITEM
    } else {
      for (int it = bid; it < 136 * 52; it += nb) g1_tile(p, it, smem);
    }
  } else if (k == 2) {
    const int n_v = MALL / 64, n_q = n_v + MALL / 32, n_l = NBATCH * NCHUNK * 16, n_t = 3 * 256;
    if ((nb & 15) == 0 && sel == 0) {
      int it = bid;
      for (; it < n_q; it += nb) {
        if (it < n_v) vt_item(p, it, smem, dry); else qk_item(p, l, it - n_v, dry);
      }
      lru1_run(p, l, it - n_q, nb, n_l, smem);
      while (it < n_q + n_l) it += nb;
      for (; it < n_q + n_l + n_t; it += nb) {
        int j = it - n_q - n_l;
        int which = j >> 8, tt = j & 255;
        const float* src = (which == 0 ? p.w_a : (which == 1 ? p.w_b : p.w_o)) + (size_t)l * 1024 * 1024;
        transpose_tile(src, 1024, 1024, p.Wt_abo + (size_t)which * 1024 * HP, HP, (tt & 15) * 64, (tt >> 4) * 64, smem);
      }
    } else {
    for (int it = bid; it < n_q + n_l + n_t; it += nb) {
      if (sel == 1 && !(it >= n_q && it < n_q + n_l)) continue;
      if (sel == 2 && (it >= n_q && it < n_q + n_l)) continue;
      if (it < n_v) {
        vt_item(p, it, smem, dry);
      } else if (it < n_q) {
        qk_item(p, l, it - n_v, dry);
      } else if (it < n_q + n_l) {
        int j = it - n_q;
        int blk = j & 15, rest = j >> 4;
        lru_item(p, l, rest / NCHUNK, rest % NCHUNK, blk, 1, smem, dry);
      } else {
        int j = it - n_q - n_l;
        int which = j >> 8, tt = j & 255;
        const float* src = (which == 0 ? p.w_a : (which == 1 ? p.w_b : p.w_o)) + (size_t)l * 1024 * 1024;
        transpose_tile(src, 1024, 1024, p.Wt_abo + (size_t)which * 1024 * HP, HP, (tt & 15) * 64, (tt >> 4) * 64, smem);
      }
    }
    }
  } else if (k == 3) {
    const int n_al = 2048, n_ac = last ? 0 : 128, n_l = NBATCH * NCHUNK * 16;
    const bool lru_first = bid >= (nb >> 1);
    for (int stage = 0; stage < 2; ++stage) {
      const bool do_lru = (stage == 0) == lru_first;
      if (do_lru) {
        if (sel == 2) continue;
        for (int j = bid; j < (n_l >> 2); j += nb) lru2_wave(p, j * 4 + (opaque_tid() >> 6), last, dry);
      } else {
        if (sel == 1) continue;
        for (int it = bid; it < n_al + n_ac; it += nb) {
          if (it < n_al) {
            int x = it & 7, j = it >> 3;
            int pair = 2 * x + (j >> 7);
            int idx = j & 127;
            int b = pair >> 2, kvh = pair & 3, g = idx & 3, qb = idx >> 2;
            attn_item(p, l, b, kvh * 4 + g, CTXL + qb * 128, TOK, smem, dry);
          } else {
            int j = it - n_al;
            int qb = j & 1, hq = (j >> 1) & 15, b = j >> 5;
            attn_item(p, l, b, hq, qb * 128, CTXL, smem, dry);
          }
        }
      }
    }
  } else {
    const int n_mt = last ? 128 : 136;
    if ((nb & 7) == 0) {
      const int xcd = bid & 7, mpx = n_mt >> 3;
      const int jstep = nb >> 3;
      bool primed = false;
      for (int j = bid >> 3; j < mpx * 8; j += jstep) {
        const int mi = xcd * mpx + (j >> 3), nt = j & 7;
        const int mt = last ? ((mi >> 5) * 34 + 2 + (mi & 31)) : mi;
        int nmt = -1, nnt = 0;
        if (j + jstep < mpx * 8) {
          const int mi2 = xcd * mpx + ((j + jstep) >> 3);
          nnt = (j + jstep) & 7;
          nmt = last ? ((mi2 >> 5) * 34 + 2 + (mi2 & 31)) : mi2;
        }
        if (k == 4) g2_tile(p, mt, nt, smem, dry, primed, nmt, nnt); else g3_tile(p, l, mt, nt, smem, dry, primed, nmt, nnt);
        primed = nmt >= 0;
      }
    } else {
      for (int it = bid; it < n_mt * 8; it += nb) {
        int mi = it >> 3, nt = it & 7;
        int mt = last ? ((mi >> 5) * 34 + 2 + (mi & 31)) : mi;
        if (k == 4) g2_tile(p, mt, nt, smem, dry); else g3_tile(p, l, mt, nt, smem, dry);
      }
    }
  }
}

__global__ void __launch_bounds__(256, 2) mega(Params p, int ph_begin, int ph_end, int coop, int dupmask) {
  extern __shared__ __attribute__((aligned(16))) char smem[];
  __shared__ uint4 xb_words;
  XcdBarrier xb;
  xb.bar = p.bar; xb.x = 0u; xb.st = (volatile LAS unsigned*)&xb_words;
  if (coop) {
    if (threadIdx.x == 0) xb_words = make_uint4(0u, 0u, 0u, 0u);
    __syncthreads();
    xb = xcd_barrier_post(p.bar, (volatile LAS unsigned*)&xb_words);
  }
  for (int ph = ph_begin; ph < ph_end; ++ph) {
    if (DUPMASK != 0 && dupmask) {
      const int kk = ph >= 2 ? (ph - 2) % 6 : 7;
      if ((dupmask >> kk) & 1) { run_phase(p, ph, smem, (dupmask & 0x100) != 0, (dupmask >> 9) & 3); if (coop == 1) xcd_barrier(xb); }
    }
    run_phase(p, ph, smem, false, 0);
    if (ph + 1 < ph_end) {
      if (coop == 1) xcd_barrier(xb);
      else if (coop == 2) cg::this_grid().sync();
    }
  }
}

extern "C" void kernel_launch(void* const* d_in, const int* in_sizes, int n_in, void* d_out, int out_size, void* d_ws,
                              size_t ws_size, hipStream_t stream) {
  Params p{};
  p.x = (const float*)d_in[0]; p.c = (const float*)d_in[1]; p.ctx = (const float*)d_in[2]; p.c_ctx = (const float*)d_in[3];
  p.norm_g = (const float*)d_in[4]; p.w_mod = (const float*)d_in[5]; p.b_mod = (const float*)d_in[6]; p.w_in = (const float*)d_in[7];
  p.q_norm_g = (const float*)d_in[8]; p.k_norm_g = (const float*)d_in[9]; p.conv_w = (const float*)d_in[10];
  p.conv_b = (const float*)d_in[11]; p.gate_w = (const float*)d_in[12]; p.gate_b = (const float*)d_in[13];
  p.lam = (const float*)d_in[14]; p.w_a = (const float*)d_in[15]; p.w_b = (const float*)d_in[16]; p.w_o = (const float*)d_in[17];
  p.out = (float*)d_out;
  char* ws = (char*)d_ws;
  size_t off = 0;
  p.P = (bf16_t*)(ws + off); off += (size_t)MALL * DIN * 2;
  p.Hs = (bf16_t*)(ws + off); p.agg = (float*)(ws + off); off += (size_t)MALL * HP * 2;
  p.Wt_in = (bf16_t*)(ws + off); p.Wt_abo = (bf16_t*)(ws + off); off += (size_t)DIN * HP * 2;
  p.Xctx = (float*)(ws + off); off += (size_t)NBATCH * CTXL * DM * 4;
  p.mod = (float*)(ws + off); off += (size_t)4 * 5 * 3072 * 4;
  p.rope = (float*)(ws + off); off += (size_t)64 * 16 * 2 * 4;
  p.bar = (unsigned*)(ws + off); off += (size_t)XCD_BAR_WORDS * 4;
  p.Wg = (bf16_t*)(ws + off); off += (size_t)262144 * 2;
  p.modp = (float*)(ws + off); off += (size_t)16 * 61440 * 4;
  p.lab = (bf16_t*)(ws + off); off += (size_t)NBATCH * NCHUNK * 16 * 32768;
  if (off > ws_size) { fprintf(stderr, "workspace too small: need %zu have %zu\n", off, ws_size); return; }

  static int grid_blocks = 0;
  if (!grid_blocks) {
    int dev = 0, cus = 0, per_cu = 0;
    hipGetDevice(&dev);
    hipDeviceGetAttribute(&cus, hipDeviceAttributeMultiprocessorCount, dev);
    hipFuncSetAttribute((const void*)mega, hipFuncAttributeMaxDynamicSharedMemorySize, SMEM_BYTES);
    hipOccupancyMaxActiveBlocksPerMultiprocessor(&per_cu, mega, 256, SMEM_BYTES);
    if (per_cu < 1) per_cu = 1;
    if (per_cu > 2) per_cu = 2;
    grid_blocks = cus * per_cu;
  }
#if MULTI
  for (int ph = 0; ph < NPH; ++ph) {
    hipLaunchKernelGGL(mega, dim3(grid_blocks), dim3(256), SMEM_BYTES, stream, p, ph, ph + 1, 0, 0);
  }
#else
  hipMemsetAsync(p.bar, 0, (size_t)XCD_BAR_WORDS * 4, stream);
  int b0 = 0, e0 = NPH, coop = 1, dupmask = DUPMASK;
  void* args[] = {&p, &b0, &e0, &coop, &dupmask};
  hipError_t e = hipLaunchCooperativeKernel((const void*)mega, dim3(grid_blocks), dim3(256), args, SMEM_BYTES, stream);
  if (e != hipSuccess) fprintf(stderr, "cooperative launch failed: %s (grid %d)\n", hipGetErrorString(e), grid_blocks);
#endif
}
```
